# Optimizing an MI355X kernel written in HIP

```python
import jax, jax.numpy as jnp
from jax import lax
import numpy as np

D_MODEL = 1024
BATCH = 1
SEQ = 16384
DEPTH = 1

ATTN_HEADS = 8
ATTN_HEAD_DIM = 64
ATTN_WIDTH = ATTN_HEADS * ATTN_HEAD_DIM
MOBA_BLOCK = 256
MOBA_TOPK = 3
Q_BLOCK = 128
MLSTM_HEADS = 4
MLSTM_HEAD_DIM = 128
MLSTM_WIDTH = MLSTM_HEADS * MLSTM_HEAD_DIM
MLSTM_CHUNK = 128
CONV_K = 4
SPLIT_SIZES = (ATTN_WIDTH, ATTN_WIDTH, ATTN_WIDTH,
               MLSTM_WIDTH, MLSTM_WIDTH, MLSTM_WIDTH, MLSTM_WIDTH,
               MLSTM_HEADS, MLSTM_HEADS,
               D_MODEL, D_MODEL)
IN_WIDTH = sum(SPLIT_SIZES)
N_GROUPS = 4
EXPERTS_PER_GROUP = 8
N_EXPERTS = N_GROUPS * EXPERTS_PER_GROUP
TOPK_IN_GROUP = 2
EXPERT_FF = 512
ROW_BLOCK = 256
PLE_DIM = 256
EPS = 1e-6

kernel_name = "hybrid_moba_mlstm_hmoe_block"


def rmsnorm(x, g):
    xf = x.astype(jnp.float32)
    y = xf * lax.rsqrt(jnp.mean(xf * xf, axis=-1, keepdims=True) + EPS)
    return (y * g.astype(jnp.float32)).astype(x.dtype)


def split_cols(t, sizes):
    outs, start = [], 0
    for s in sizes:
        outs.append(t[..., start:start + s])
        start += s
    return outs


def to_heads(t, n_heads):
    b, s, _ = t.shape
    return t.reshape(b, s, n_heads, -1).transpose(0, 2, 1, 3)


def from_heads(t):
    b, h, s, d = t.shape
    return t.transpose(0, 2, 1, 3).reshape(b, s, h * d)


def causal_dwconv(x, w, b):
    s = x.shape[1]
    xp = jnp.pad(x, ((0, 0), (CONV_K - 1, 0), (0, 0)))
    y = b
    for k in range(CONV_K):
        y = y + xp[:, k:k + s, :] * w[k]
    return y


def moba_attention(q, k, v):
    b, h, s, d = q.shape
    nb = -(-s // MOBA_BLOCK)
    pad = nb * MOBA_BLOCK - s
    kp = jnp.pad(k, ((0, 0), (0, 0), (0, pad), (0, 0)))
    vp = jnp.pad(v, ((0, 0), (0, 0), (0, pad), (0, 0)))
    kb = kp.reshape(b, h, nb, MOBA_BLOCK, d)
    vb = vp.reshape(b, h, nb, MOBA_BLOCK, d)
    kmean = jnp.mean(kb.astype(jnp.float32), axis=3)
    topk = min(MOBA_TOPK, nb)
    scale = ATTN_HEAD_DIM ** -0.5
    b_idx = jnp.arange(b)[:, None, None, None]
    h_idx = jnp.arange(h)[None, :, None, None]
    n_qblocks = s // Q_BLOCK

    def block_fn(qi):
        q0 = qi * Q_BLOCK
        qb = lax.dynamic_slice_in_dim(q, q0, Q_BLOCK, axis=2)
        qpos = q0 + jnp.arange(Q_BLOCK)
        cur = q0 // MOBA_BLOCK
        gate = jnp.einsum('bhqd,bhnd->bhqn', qb.astype(jnp.float32), kmean)
        gate = jnp.where(jnp.arange(nb) < cur, gate, -jnp.inf)
        _, sel = lax.top_k(gate, topk)
        sel_valid = jnp.arange(topk) < cur
        ks = kb[b_idx, h_idx, sel]
        vs = vb[b_idx, h_idx, sel]
        s_sel = jnp.einsum('bhqd,bhqjkd->bhqjk', qb, ks).astype(jnp.float32) * scale
        s_sel = jnp.where(sel_valid[:, None], s_sel, -jnp.inf)
        s_sel = s_sel.reshape(b, h, Q_BLOCK, topk * MOBA_BLOCK)
        ko = lax.dynamic_slice_in_dim(kp, cur * MOBA_BLOCK, MOBA_BLOCK, axis=2)
        vo = lax.dynamic_slice_in_dim(vp, cur * MOBA_BLOCK, MOBA_BLOCK, axis=2)
        kpos = cur * MOBA_BLOCK + jnp.arange(MOBA_BLOCK)
        s_own = jnp.einsum('bhqd,bhkd->bhqk', qb, ko).astype(jnp.float32) * scale
        s_own = jnp.where(kpos[None, :] <= qpos[:, None], s_own, -jnp.inf)
        probs = jax.nn.softmax(jnp.concatenate([s_sel, s_own], axis=-1), axis=-1)
        p_sel = probs[..., :topk * MOBA_BLOCK].reshape(b, h, Q_BLOCK, topk, MOBA_BLOCK).astype(v.dtype)
        p_own = probs[..., topk * MOBA_BLOCK:].astype(v.dtype)
        return (jnp.einsum('bhqjk,bhqjkd->bhqd', p_sel, vs)
                + jnp.einsum('bhqk,bhkd->bhqd', p_own, vo))

    out = lax.map(block_fn, jnp.arange(n_qblocks))
    return jnp.moveaxis(out, 0, 2).reshape(b, h, s, d)


def mlstm_chunkwise(q, k, v, i_pre, f_pre):
    b, h, s, dk = q.shape
    dv = v.shape[-1]
    L = MLSTM_CHUNK
    nc = s // L
    f32 = jnp.float32
    log_f = jax.nn.log_sigmoid(f_pre.astype(f32))
    log_i = i_pre.astype(f32)

    def chunks(t):
        return jnp.moveaxis(t.reshape(b, h, nc, L, *t.shape[3:]), 2, 0)

    xs = (chunks(q.astype(f32)), chunks(k.astype(f32)), chunks(v.astype(f32)), chunks(log_i), chunks(log_f))
    causal = jnp.tril(jnp.ones((L, L), dtype=bool))

    def step(carry, inp):
        C, n, m = carry
        qc, kc, vc, lic, lfc = inp
        bcum = jnp.cumsum(lfc, axis=-1)
        dmat = bcum[..., :, None] - bcum[..., None, :] + lic[..., None, :]
        dmat = jnp.where(causal, dmat, -jnp.inf)
        inter = bcum + m[..., None]
        m_t = jnp.maximum(inter, jnp.max(dmat, axis=-1))
        w_ts = jnp.exp(dmat - m_t[..., None])
        sc_inter = jnp.exp(inter - m_t)
        sqk = jnp.einsum('bhtd,bhsd->bhts', qc, kc) * w_ts
        num = (jnp.einsum('bhts,bhsv->bhtv', sqk, vc)
               + sc_inter[..., None] * jnp.einsum('bhtd,bhdv->bhtv', qc, C))
        den = jnp.sum(sqk, axis=-1) + sc_inter * jnp.einsum('bhtd,bhd->bht', qc, n)
        h_t = num / jnp.maximum(jnp.abs(den), jnp.exp(-m_t))[..., None]
        b_last = bcum[..., -1]
        lw = b_last[..., None] - bcum + lic
        m_new = jnp.maximum(b_last + m, jnp.max(lw, axis=-1))
        w_s = jnp.exp(lw - m_new[..., None])
        decay = jnp.exp(b_last + m - m_new)
        C_new = decay[..., None, None] * C + jnp.einsum('bhsd,bhsv->bhdv', kc * w_s[..., None], vc)
        n_new = decay[..., None] * n + jnp.einsum('bhs,bhsd->bhd', w_s, kc)
        return (C_new, n_new, m_new), h_t

    init = (jnp.zeros((b, h, dk, dv), f32), jnp.zeros((b, h, dk), f32), jnp.zeros((b, h), f32))
    _, hs = lax.scan(step, init, xs)
    return jnp.moveaxis(hs, 0, 2).reshape(b, h, s, dv)


def hierarchical_moe(xn, rg_w, rg_b, re_w, re_b, w_gate, w_up, w_down):
    b, s, d = xn.shape
    T = b * s
    xt = xn.reshape(T, d)
    g_logits = (xt @ rg_w + rg_b).astype(jnp.float32)
    g_prob = jax.nn.softmax(g_logits, axis=-1)
    grp = jnp.argmax(g_logits, axis=-1)
    p_grp = jnp.take_along_axis(g_prob, grp[:, None], axis=-1)[:, 0]
    e_logits = (xt @ re_w + re_b).astype(jnp.float32).reshape(T, N_GROUPS, EXPERTS_PER_GROUP)
    e_logits = jnp.take_along_axis(e_logits, grp[:, None, None], axis=1)[:, 0]
    e_prob = jax.nn.softmax(e_logits, axis=-1)
    w_top, i_top = lax.top_k(e_prob, TOPK_IN_GROUP)
    w_top = w_top / jnp.sum(w_top, axis=-1, keepdims=True) * p_grp[:, None]
    eid = grp[:, None] * EXPERTS_PER_GROUP + i_top

    A = T * TOPK_IN_GROUP
    flat_e = eid.reshape(A)
    flat_tok = jnp.repeat(jnp.arange(T, dtype=jnp.int32), TOPK_IN_GROUP)
    flat_w = w_top.reshape(A)
    order = jnp.argsort(flat_e)
    se, stok, sw = flat_e[order], flat_tok[order], flat_w[order]
    counts = jax.ops.segment_sum(jnp.ones((A,), jnp.int32), flat_e, num_segments=N_EXPERTS)
    offsets = jnp.cumsum(counts) - counts
    pcounts = (counts + ROW_BLOCK - 1) // ROW_BLOCK * ROW_BLOCK
    pends = jnp.cumsum(pcounts)
    poffs = pends - pcounts
    dest = poffs[se] + (jnp.arange(A, dtype=jnp.int32) - offsets[se])
    n_pad = (A + N_EXPERTS * (ROW_BLOCK - 1) + ROW_BLOCK - 1) // ROW_BLOCK * ROW_BLOCK
    n_blk = n_pad // ROW_BLOCK
    row_tok = jnp.zeros((n_pad,), jnp.int32).at[dest].set(stok)
    row_w = jnp.zeros((n_pad,), jnp.float32).at[dest].set(sw)
    blk_e = jnp.minimum(jnp.searchsorted(pends, jnp.arange(n_blk) * ROW_BLOCK, side='right'),
                        N_EXPERTS - 1)

    def blk(args):
        bi, e = args
        toks = lax.dynamic_slice_in_dim(row_tok, bi * ROW_BLOCK, ROW_BLOCK)
        wr = lax.dynamic_slice_in_dim(row_w, bi * ROW_BLOCK, ROW_BLOCK)
        xb = xt[toks]
        hid = jax.nn.silu(xb @ w_gate[e]) * (xb @ w_up[e])
        return ((hid @ w_down[e]) * wr[:, None]).astype(xt.dtype)

    yb = lax.map(blk, (jnp.arange(n_blk), blk_e))
    y = jax.ops.segment_sum(yb.reshape(n_pad, d), row_tok, num_segments=T)
    return y.reshape(b, s, d)


def setup_inputs(seed: int = 0) -> dict:
    key = jax.random.key(seed)
    ks = jax.random.split(key, 24)
    nrm = jax.random.normal
    L = DEPTH
    f32 = jnp.float32

    def gain(k, n):
        return 1.0 + 0.01 * nrm(k, (L, n), f32)

    if_b = jnp.concatenate([0.1 * nrm(ks[6], (L, MLSTM_HEADS), f32),
                            3.0 + 3.0 * jax.random.uniform(ks[7], (L, MLSTM_HEADS), f32)], axis=-1)
    return {
        "x": nrm(ks[0], (BATCH, SEQ, D_MODEL), f32),
        "p": nrm(ks[1], (DEPTH, BATCH, SEQ, PLE_DIM), f32),
        "mix_norm_g": gain(ks[2], D_MODEL),
        "w_in": nrm(ks[3], (L, D_MODEL, IN_WIDTH), f32) * D_MODEL ** -0.5,
        "b_gate": 0.01 * nrm(ks[4], (L, 2 * D_MODEL), f32),
        "conv_w": nrm(ks[5], (L, CONV_K, 2 * MLSTM_WIDTH), f32) * CONV_K ** -0.5,
        "conv_b": 0.01 * nrm(ks[8], (L, 2 * MLSTM_WIDTH), f32),
        "mlstm_if_b": if_b,
        "mlstm_norm_g": gain(ks[9], MLSTM_WIDTH),
        "w_up_attn": nrm(ks[10], (L, ATTN_WIDTH, D_MODEL), f32) * ATTN_WIDTH ** -0.5,
        "w_up_mlstm": nrm(ks[11], (L, MLSTM_WIDTH, D_MODEL), f32) * MLSTM_WIDTH ** -0.5,
        "w_out": nrm(ks[12], (L, D_MODEL, D_MODEL), f32) * D_MODEL ** -0.5,
        "ffn_norm_g": gain(ks[13], D_MODEL),
        "router_group_w": nrm(ks[14], (L, D_MODEL, N_GROUPS), f32) * D_MODEL ** -0.5,
        "router_group_b": 0.01 * nrm(ks[15], (L, N_GROUPS), f32),
        "router_expert_w": nrm(ks[16], (L, D_MODEL, N_EXPERTS), f32) * D_MODEL ** -0.5,
        "router_expert_b": 0.01 * nrm(ks[17], (L, N_EXPERTS), f32),
        "expert_w_gate": nrm(ks[18], (L, N_EXPERTS, D_MODEL, EXPERT_FF), f32) * D_MODEL ** -0.5,
        "expert_w_up": nrm(ks[19], (L, N_EXPERTS, D_MODEL, EXPERT_FF), f32) * D_MODEL ** -0.5,
        "expert_w_down": nrm(ks[20], (L, N_EXPERTS, EXPERT_FF, D_MODEL), f32) * EXPERT_FF ** -0.5,
        "ple_norm_g": gain(ks[21], D_MODEL),
        "w_ple_gate": nrm(ks[22], (L, D_MODEL, D_MODEL), f32) * D_MODEL ** -0.5,
        "w_ple_proj": nrm(ks[23], (L, PLE_DIM, D_MODEL), f32) * PLE_DIM ** -0.5,
        "final_norm_g": 1.0 + 0.01 * nrm(jax.random.fold_in(key, 99), (D_MODEL,), f32),
    }


def reference(x, p, mix_norm_g, w_in, b_gate, conv_w, conv_b, mlstm_if_b, mlstm_norm_g,
              w_up_attn, w_up_mlstm, w_out, ffn_norm_g, router_group_w, router_group_b,
              router_expert_w, router_expert_b, expert_w_gate, expert_w_up, expert_w_down,
              ple_norm_g, w_ple_gate, w_ple_proj, final_norm_g):
    h = x
    for i in range(DEPTH):
        xn = rmsnorm(h, mix_norm_g[i])
        proj = xn @ w_in[i]
        aq, ak, av, mq, mk, mv, mo, mi, mf, ga, gm = split_cols(proj, SPLIT_SIZES)
        ya = from_heads(moba_attention(to_heads(aq, ATTN_HEADS), to_heads(ak, ATTN_HEADS),
                                       to_heads(av, ATTN_HEADS)))
        qk = jax.nn.silu(causal_dwconv(jnp.concatenate([mq, mk], axis=-1), conv_w[i], conv_b[i]))
        mq_c, mk_c = qk[..., :MLSTM_WIDTH], qk[..., MLSTM_WIDTH:]
        i_pre = (mi + mlstm_if_b[i, :MLSTM_HEADS]).transpose(0, 2, 1)
        f_pre = (mf + mlstm_if_b[i, MLSTM_HEADS:]).transpose(0, 2, 1)
        h_tilde = mlstm_chunkwise(to_heads(mq_c, MLSTM_HEADS),
                                  to_heads(mk_c, MLSTM_HEADS) * MLSTM_HEAD_DIM ** -0.5,
                                  to_heads(mv, MLSTM_HEADS), i_pre, f_pre)
        h_cell = jax.nn.sigmoid(to_heads(mo, MLSTM_HEADS).astype(jnp.float32)) * h_tilde
        h_cell = rmsnorm(h_cell, mlstm_norm_g[i].reshape(MLSTM_HEADS, 1, MLSTM_HEAD_DIM))
        ym = from_heads(h_cell).astype(h.dtype)
        gates = jax.nn.sigmoid(jnp.concatenate([ga, gm], axis=-1) + b_gate[i])
        merged = (gates[..., :D_MODEL] * (ya @ w_up_attn[i])
                  + gates[..., D_MODEL:] * (ym @ w_up_mlstm[i]))
        h = h + merged @ w_out[i]
        h = h + hierarchical_moe(rmsnorm(h, ffn_norm_g[i]), router_group_w[i], router_group_b[i],
                                 router_expert_w[i], router_expert_b[i], expert_w_gate[i],
                                 expert_w_up[i], expert_w_down[i])
        ple_gate = jax.nn.sigmoid(rmsnorm(h, ple_norm_g[i]) @ w_ple_gate[i])
        h = h + (p[i] @ w_ple_proj[i]) * ple_gate
    return rmsnorm(h, final_norm_g)
```

```cpp
#include <hip/hip_runtime.h>
#include <cstdio>
#include <cstdint>
#define MK_PER_PHASE 0
#define MK_MASK 0x7fff
#define MK_P3 7
namespace pg8 {
#define PG8_LAS __attribute__((address_space(3)))
typedef unsigned short bf16_t;
typedef short bf16x8 __attribute__((ext_vector_type(8)));
typedef float f32x4 __attribute__((ext_vector_type(4)));
typedef unsigned u32x4 __attribute__((ext_vector_type(4)));
constexpr int BM = 256, BK = 64, HALF = 128, HTB = HALF * BK * 2  , STAGE_BYTES = 8 * HTB, NXCD = 8, WGM = 8;

__host__ __device__ __forceinline__ int lds_byte(int r, int c) { const int st = (r >> 4) * 2 + (c >> 5), rr = r & 15, cc = c & 31, ob = rr * 64 + cc * 2; return st * 1024 + (ob ^ (((ob >> 9) & 1) << 5)); }
__host__ __device__ __forceinline__ void stage_rc(int b, int& R, int& C) { const int st = b / 1024, sb = b % 1024, swz = sb ^ (((sb >> 9) & 1) << 5); R = (st >> 1) * 16 + swz / 64; C = (st & 1) * 32 + (swz % 64) / 2; }
__host__ __device__ __forceinline__ int perm32(int rho) { const int n = rho >> 4, i = rho & 15; return 8 * (i >> 2) + 4 * n + (i & 3); }

struct Unit { int pm, pn; };
struct Gemm { const bf16_t* A; const bf16_t* Bt; int M, N, K; };

struct StaticOrder {
    int nM, nN, nwg, G, c;
    __host__ __device__ void init(int M, int N, int G_, int c_) { nM = M / BM; nN = N / BM; nwg = nM * nN; G = G_; c = c_; }
    __host__ __device__ bool next(int i, Unit& u) const {
        const long L = (long)i * G + c; if (L >= nwg) return false;
        int wgid = (int)L; { const int q = nwg / NXCD, r = nwg % NXCD, xcd = wgid % NXCD, off = wgid / NXCD; wgid = (xcd < r ? xcd * (q + 1) : r * (q + 1) + (xcd - r) * q) + off; }
        const int nig = WGM * nN, gid = wgid / nig, fm = gid * WGM, gsz = (nM - fm) < WGM ? (nM - fm) : WGM;
        u.pm = fm + ((wgid % nig) % gsz); u.pn = (wgid % nig) / gsz; return true;
    }
    __device__ __forceinline__ void a_ready(const Unit&) const {}
    __device__ __forceinline__ void done(const Unit&) const {}
};

typedef float f32x2c __attribute__((ext_vector_type(2)));
typedef __bf16 bf16x2c __attribute__((ext_vector_type(2)));
__device__ __forceinline__ unsigned cvt_pk_bf16(float lo, float hi) { const f32x2c v = {lo, hi}; const bf16x2c b = __builtin_convertvector(v, bf16x2c); return __builtin_bit_cast(unsigned, b); }
typedef float f32x2 __attribute__((ext_vector_type(2)));
__device__ __forceinline__ f32x2 gelu_pk(f32x2 v) {
    const f32x2 av = __builtin_elementwise_abs(v), d = av * 0.2316418882f + 1.0f;
    f32x2 t; t.x = __builtin_amdgcn_rcpf(d.x); t.y = __builtin_amdgcn_rcpf(d.y);
    f32x2 q = t * 0.5307027145f + (-0.7265760135f); q = q * t + 0.7107068705f; q = q * t + (-0.142248368f); q = q * t + 0.127414796f; q = q * t;
    const f32x2 s = (v * v) * (-0.72134752044f);
    f32x2 e; e.x = __builtin_amdgcn_exp2f(s.x); e.y = __builtin_amdgcn_exp2f(s.y);
    const f32x2 m = v * (q * e), r = v - m;
    f32x2 o; o.x = v.x < 0.f ? m.x : r.x; o.y = v.y < 0.f ? m.y : r.y; return o;
}

template <int ACT  > struct EpiBf16 {
    static constexpr bool PERM = true, AFTER_DRAIN = false; static_assert(ACT == 0 || ACT == 1, "EpiBf16: ACT is 0 (none) or 1 (gelu_pk)");
    bf16_t* O; int ldc; const float* bias; int split_cols; size_t split_stride; float scale0;
    __device__ __forceinline__ void operator()(const f32x4 (&acc)[2][2][4][2], const Unit& u, int wr, int wc, int fr, int fq) const {
        const int row0 = u.pm * BM + wr * 64 + fr; int colt = u.pn * BM; bf16_t* base = O;
        float sc = 1.f; if (split_cols) { const int t = colt / split_cols; base += (size_t)t * split_stride; colt -= t * split_cols; if (t == 0) sc = scale0; }
        const int col0 = colt + wc * 32 + 8 * fq, bcol0 = u.pn * BM + wc * 32 + 8 * fq;
        f32x4 bv[2][2];
#pragma unroll
        for (int bj = 0; bj < 2; ++bj)
#pragma unroll
            for (int n = 0; n < 2; ++n) bv[bj][n] = bias ? *(const f32x4*)(bias + bcol0 + bj * HALF + 4 * n) : (f32x4){0.f, 0.f, 0.f, 0.f};
#pragma unroll
        for (int ai = 0; ai < 2; ++ai)
#pragma unroll
            for (int m = 0; m < 4; ++m) { bf16_t* rowp = base + (size_t)(row0 + ai * HALF + m * 16) * ldc + col0;
#pragma unroll
                for (int bj = 0; bj < 2; ++bj) { f32x4 v0 = acc[ai][bj][m][0] + bv[bj][0], v1 = acc[ai][bj][m][1] + bv[bj][1];
                    if (ACT == 1) { f32x2 a = gelu_pk((f32x2){v0[0], v0[1]}), b = gelu_pk((f32x2){v0[2], v0[3]}), c = gelu_pk((f32x2){v1[0], v1[1]}), d = gelu_pk((f32x2){v1[2], v1[3]});
                        v0 = (f32x4){a.x, a.y, b.x, b.y}; v1 = (f32x4){c.x, c.y, d.x, d.y}; }
                    v0 = v0 * sc; v1 = v1 * sc; u32x4 w; w.x = cvt_pk_bf16(v0[0], v0[1]); w.y = cvt_pk_bf16(v0[2], v0[3]); w.z = cvt_pk_bf16(v1[0], v1[1]); w.w = cvt_pk_bf16(v1[2], v1[3]);
                    *(u32x4*)(rowp + bj * HALF) = w; } }
    }
};

constexpr int TT = 16384;
typedef unsigned u32x2 __attribute__((ext_vector_type(2)));
__device__ __forceinline__ float sigm(float x) { return __builtin_amdgcn_rcpf(1.0f + __expf(-x)); }
__device__ __forceinline__ float bf_lo(unsigned w) { return __uint_as_float(w << 16); }
__device__ __forceinline__ float bf_hi(unsigned w) { return __uint_as_float(w & 0xffff0000u); }
__device__ __forceinline__ u32x4 pack8(const f32x4& a, const f32x4& b) { u32x4 w; w.x = cvt_pk_bf16(a[0], a[1]); w.y = cvt_pk_bf16(a[2], a[3]); w.z = cvt_pk_bf16(b[0], b[1]); w.w = cvt_pk_bf16(b[2], b[3]); return w; }

struct EpiG1 {
    static constexpr bool PERM = true, AFTER_DRAIN = false;
    bf16_t* O7; bf16_t* GA; const float* bgate;
    __device__ __forceinline__ void operator()(const f32x4 (&acc)[2][2][4][2], const Unit& u, int wr, int wc, int fr, int fq) const {
        const int row0 = u.pm * BM + wr * 64 + fr; const int pn = u.pn;
        if (pn < 14) {
            bf16_t* base = O7 + (size_t)(pn >> 1) * ((size_t)TT * 512); const int col0 = (pn & 1) * 256 + wc * 32 + 8 * fq; const float sc = pn < 2 ? 0.125f : 1.0f;
#pragma unroll
            for (int ai = 0; ai < 2; ++ai)
#pragma unroll
                for (int m = 0; m < 4; ++m) { bf16_t* rowp = base + (size_t)(row0 + ai * HALF + m * 16) * 512 + col0;
#pragma unroll
                    for (int bj = 0; bj < 2; ++bj) *(u32x4*)(rowp + bj * HALF) = pack8(acc[ai][bj][m][0] * sc, acc[ai][bj][m][1] * sc); }
        } else {
            const int gi = (pn - 14) >> 2, col0 = ((pn - 14) & 3) * 256 + wc * 32 + 8 * fq; bf16_t* base = GA + (size_t)gi * ((size_t)TT * 1024); const float* bp = bgate + gi * 1024 + col0;
            f32x4 bv[2][2];
#pragma unroll
            for (int bj = 0; bj < 2; ++bj)
#pragma unroll
                for (int n = 0; n < 2; ++n) bv[bj][n] = *(const f32x4*)(bp + bj * HALF + 4 * n);
#pragma unroll
            for (int ai = 0; ai < 2; ++ai)
#pragma unroll
                for (int m = 0; m < 4; ++m) { bf16_t* rowp = base + (size_t)(row0 + ai * HALF + m * 16) * 1024 + col0;
#pragma unroll
                    for (int bj = 0; bj < 2; ++bj) { f32x4 v0 = acc[ai][bj][m][0] + bv[bj][0], v1 = acc[ai][bj][m][1] + bv[bj][1];
#pragma unroll
                        for (int e = 0; e < 4; ++e) { v0[e] = sigm(v0[e]); v1[e] = sigm(v1[e]); }
                        *(u32x4*)(rowp + bj * HALF) = pack8(v0, v1); } }
        }
    }
};
struct EpiGateMul {
    static constexpr bool PERM = true, AFTER_DRAIN = false;
    const bf16_t* Gt; const bf16_t* Add; bf16_t* Out;
    __device__ __forceinline__ void operator()(const f32x4 (&acc)[2][2][4][2], const Unit& u, int wr, int wc, int fr, int fq) const {
        const int row0 = u.pm * BM + wr * 64 + fr, col0 = u.pn * BM + wc * 32 + 8 * fq;
#pragma unroll
        for (int ai = 0; ai < 2; ++ai)
#pragma unroll
            for (int m = 0; m < 4; ++m) { const size_t off = (size_t)(row0 + ai * HALF + m * 16) * 1024 + col0;
#pragma unroll
                for (int bj = 0; bj < 2; ++bj) { const u32x4 g = *(const u32x4*)(Gt + off + bj * HALF);
                    f32x4 v0 = acc[ai][bj][m][0], v1 = acc[ai][bj][m][1];
                    v0[0] *= bf_lo(g.x); v0[1] *= bf_hi(g.x); v0[2] *= bf_lo(g.y); v0[3] *= bf_hi(g.y); v1[0] *= bf_lo(g.z); v1[1] *= bf_hi(g.z); v1[2] *= bf_lo(g.w); v1[3] *= bf_hi(g.w);
                    if (Add) { const u32x4 a = *(const u32x4*)(Add + off + bj * HALF);
                        v0[0] += bf_lo(a.x); v0[1] += bf_hi(a.x); v0[2] += bf_lo(a.y); v0[3] += bf_hi(a.y); v1[0] += bf_lo(a.z); v1[1] += bf_hi(a.z); v1[2] += bf_lo(a.w); v1[3] += bf_hi(a.w); }
                    *(u32x4*)(Out + off + bj * HALF) = pack8(v0, v1); } }
    }
};
struct EpiResF32 {
    static constexpr bool PERM = false, AFTER_DRAIN = false;
    const float* base; float* out;
    __device__ __forceinline__ void operator()(const f32x4 (&acc)[2][2][4][2], const Unit& u, int wr, int wc, int fr, int fq) const {
        const int row0 = u.pm * BM + wr * 64 + fr, col0 = u.pn * BM + wc * 32 + 4 * fq;
#pragma unroll
        for (int ai = 0; ai < 2; ++ai)
#pragma unroll
            for (int m = 0; m < 4; ++m) { const size_t off = (size_t)(row0 + ai * HALF + m * 16) * 1024 + col0;
#pragma unroll
                for (int bj = 0; bj < 2; ++bj)
#pragma unroll
                    for (int n = 0; n < 2; ++n) *(f32x4*)(out + off + bj * HALF + n * 16) = *(const f32x4*)(base + off + bj * HALF + n * 16) + acc[ai][bj][m][n]; }
    }
};
struct EpiMoeUp {
    static constexpr bool PERM = true, AFTER_DRAIN = false;
    bf16_t* HID;
    __device__ __forceinline__ void operator()(const f32x4 (&acc)[2][2][4][2], const Unit& u, int wr, int wc, int fr, int fq) const {
        const int row0 = u.pm * BM + wr * 64 + fr, col0 = (u.pn & 3) * 128 + wc * 32 + 8 * fq;
#pragma unroll
        for (int ai = 0; ai < 2; ++ai)
#pragma unroll
            for (int m = 0; m < 4; ++m) { f32x4 h0, h1;
#pragma unroll
                for (int e = 0; e < 4; ++e) { const float g0 = acc[ai][0][m][0][e], g1 = acc[ai][0][m][1][e]; h0[e] = g0 * sigm(g0) * acc[ai][1][m][0][e]; h1[e] = g1 * sigm(g1) * acc[ai][1][m][1][e]; }
                *(u32x4*)(HID + (size_t)(row0 + ai * HALF + m * 16) * 512 + col0) = pack8(h0, h1); }
    }
};
struct EpiMoeDown {
    static constexpr bool PERM = true, AFTER_DRAIN = false;
    bf16_t* YB; const float* roww;
    __device__ __forceinline__ void operator()(const f32x4 (&acc)[2][2][4][2], const Unit& u, int wr, int wc, int fr, int fq) const {
        const int row0 = u.pm * BM + wr * 64 + fr, col0 = (u.pn & 3) * 256 + wc * 32 + 8 * fq;
#pragma unroll
        for (int ai = 0; ai < 2; ++ai)
#pragma unroll
            for (int m = 0; m < 4; ++m) { const int r = row0 + ai * HALF + m * 16; const float w = roww[r]; bf16_t* rowp = YB + (size_t)r * 1024 + col0;
#pragma unroll
                for (int bj = 0; bj < 2; ++bj) *(u32x4*)(rowp + bj * HALF) = pack8(acc[ai][bj][m][0] * w, acc[ai][bj][m][1] * w); }
    }
};
struct EpiPlain {
    static constexpr bool PERM = true, AFTER_DRAIN = false;
    bf16_t* Out;
    __device__ __forceinline__ void operator()(const f32x4 (&acc)[2][2][4][2], const Unit& u, int wr, int wc, int fr, int fq) const {
        const int row0 = u.pm * BM + wr * 64 + fr, col0 = u.pn * BM + wc * 32 + 8 * fq;
#pragma unroll
        for (int ai = 0; ai < 2; ++ai)
#pragma unroll
            for (int m = 0; m < 4; ++m) { bf16_t* rowp = Out + (size_t)(row0 + ai * HALF + m * 16) * 1024 + col0;
#pragma unroll
                for (int bj = 0; bj < 2; ++bj) *(u32x4*)(rowp + bj * HALF) = pack8(acc[ai][bj][m][0], acc[ai][bj][m][1]); }
    }
};
struct EpiPleGate {
    static constexpr bool PERM = true, AFTER_DRAIN = false;
    const bf16_t* PJ; float* out;
    __device__ __forceinline__ void operator()(const f32x4 (&acc)[2][2][4][2], const Unit& u, int wr, int wc, int fr, int fq) const {
        const int row0 = u.pm * BM + wr * 64 + fr, col0 = u.pn * BM + wc * 32 + 8 * fq;
#pragma unroll
        for (int ai = 0; ai < 2; ++ai)
#pragma unroll
            for (int m = 0; m < 4; ++m) { const size_t off = (size_t)(row0 + ai * HALF + m * 16) * 1024 + col0;
#pragma unroll
                for (int bj = 0; bj < 2; ++bj) { const u32x4 p = *(const u32x4*)(PJ + off + bj * HALF);
                    f32x4 o0 = *(const f32x4*)(out + off + bj * HALF), o1 = *(const f32x4*)(out + off + bj * HALF + 4);
                    const f32x4 a0 = acc[ai][bj][m][0], a1 = acc[ai][bj][m][1];
                    o0[0] += bf_lo(p.x) * sigm(a0[0]); o0[1] += bf_hi(p.x) * sigm(a0[1]); o0[2] += bf_lo(p.y) * sigm(a0[2]); o0[3] += bf_hi(p.y) * sigm(a0[3]);
                    o1[0] += bf_lo(p.z) * sigm(a1[0]); o1[1] += bf_hi(p.z) * sigm(a1[1]); o1[2] += bf_lo(p.w) * sigm(a1[2]); o1[3] += bf_hi(p.w) * sigm(a1[3]);
                    *(f32x4*)(out + off + bj * HALF) = o0; *(f32x4*)(out + off + bj * HALF + 4) = o1; }
                asm volatile("" ::: "memory"); }
    }
};
struct MoeOrder {
    const int* blke; int nunits, G, c;
    __device__ __forceinline__ bool next(int i, Unit& u) const { const int U = i * G + c; if (U >= nunits) return false; const int b = U >> 2; u.pm = b; u.pn = blke[b] * 4 + (U & 3); return true; }
    __device__ __forceinline__ void a_ready(const Unit&) const {}
    __device__ __forceinline__ void done(const Unit&) const {}
};
template <class Epi, class Sched, bool ALIGN_EPI = false, bool SP2 = false>
__device__ __forceinline__ void gemm_phase(PG8_LAS unsigned char* lds, const Gemm g, const Sched& S, const Epi& E, const int wave_id  ) {
    int lane_; asm volatile("v_mbcnt_lo_u32_b32 %0, -1, 0\n\tv_mbcnt_hi_u32_b32 %0, -1, %0" : "=v"(lane_));
    const int tid_ = wave_id * 64 + lane_;
    const int tid = tid_, wid = __builtin_amdgcn_readfirstlane(tid >> 6), lane = tid & 63, wr = wid >> 2, wc = wid & 3, fr = lane & 15, fq = lane >> 4;
    int K_ = g.K; asm volatile("" : "+s"(K_));
    const int K = K_, nt = K / BK;
    unsigned voffA[2], voffB[2];
#pragma unroll
    for (int i = 0; i < 2; ++i) { int R, C; stage_rc(tid * 16 + i * 8192, R, C); const int Rb = Epi::PERM ? ((R & ~31) + perm32(R & 31)) : R;
        voffA[i] = (unsigned)(R * K + C) * 2u; voffB[i] = (unsigned)(Rb * K + C) * 2u; }
    const size_t kstep = (size_t)(BK * 2);
    const size_t hstep = (size_t)HALF * K * 2;
    const size_t tstep = 2 * hstep;
    const unsigned ldsw = (unsigned)wid * 1024u;
    const int aoff = lds_byte(wr * 64 + fr, fq * 8), boff = lds_byte(wc * 32 + fr, fq * 8);
#define PG8_SA(b, h) (((b) * 2 + (h)) * HTB)
#define PG8_SB(b, h) ((4 + (b) * 2 + (h)) * HTB)
#define PG8_STAGE(bufoff, gbase, voff) do { _Pragma("unroll") for (int _i = 0; _i < 2; ++_i) \
        __builtin_amdgcn_global_load_lds((const unsigned*)((const char*)(gbase) + (voff)[_i]), (PG8_LAS unsigned*)(lds + (bufoff) + ldsw + _i * 8192), 16, 0, 0); } while (0)
#define PG8_LDA(dst, b, h) do { _Pragma("unroll") for (int m = 0; m < 4; ++m) _Pragma("unroll") for (int k = 0; k < 2; ++k) dst[m][k] = *(const PG8_LAS bf16x8*)(lds + PG8_SA(b, h) + aoff + m * 2048 + k * 1024); } while (0)
#define PG8_LDB(dst, b, h) do { _Pragma("unroll") for (int n = 0; n < 2; ++n) _Pragma("unroll") for (int k = 0; k < 2; ++k) dst[n][k] = *(const PG8_LAS bf16x8*)(lds + PG8_SB(b, h) + boff + n * 2048 + k * 1024); } while (0)
#define PG8_MMA(ai, bj, At, Bt) do { __builtin_amdgcn_s_setprio(1); _Pragma("unroll") for (int m = 0; m < 4; ++m) _Pragma("unroll") for (int n = 0; n < 2; ++n) _Pragma("unroll") for (int k = 0; k < 2; ++k) \
        acc[ai][bj][m][n] = __builtin_amdgcn_mfma_f32_16x16x32_bf16(Bt[n][k], At[m][k], acc[ai][bj][m][n], 0, 0, 0); __builtin_amdgcn_s_setprio(0); } while (0)
#define PG8_WAIT_V(n) asm volatile("s_waitcnt vmcnt(" #n ")" ::: "memory")
#define PG8_WAIT_L(n) asm volatile("s_waitcnt lgkmcnt(" #n ")" ::: "memory")
#define PG8_BAR __builtin_amdgcn_s_barrier()
#define PG8_SCHED __builtin_amdgcn_sched_barrier(0)
    Unit cur, nxt; int ui = 0;
    if (!S.next(0, cur)) return;
    f32x4 acc[2][2][4][2];
#pragma unroll
    for (int a = 0; a < 2; ++a)
#pragma unroll
        for (int b = 0; b < 2; ++b)
#pragma unroll
            for (int m = 0; m < 4; ++m)
#pragma unroll
                for (int n = 0; n < 2; ++n) acc[a][b][m][n] = (f32x4){0.f, 0.f, 0.f, 0.f};
    bf16x8 At[4][2], B0[2][2], B1[2][2];
    const char* cA = (const char*)g.A + (size_t)cur.pm * tstep; const char* cB = (const char*)g.Bt + (size_t)cur.pn * tstep;
    S.a_ready(cur);
    if constexpr (SP2) {
        PG8_STAGE(PG8_SB(0, 0), cB, voffB); PG8_STAGE(PG8_SB(0, 1), cB + hstep, voffB); PG8_STAGE(PG8_SA(0, 0), cA, voffA); PG8_STAGE(PG8_SA(0, 1), cA + hstep, voffA);
        if (wr == 1) PG8_BAR;
        PG8_WAIT_V(2); PG8_BAR;
        PG8_STAGE(PG8_SB(1, 0), cB + kstep, voffB); PG8_STAGE(PG8_SA(1, 0), cA + kstep, voffA); PG8_STAGE(PG8_SB(1, 1), cB + hstep + kstep, voffB);
        PG8_WAIT_V(6); PG8_BAR;
    } else {
        PG8_STAGE(PG8_SB(0, 0), cB, voffB); PG8_STAGE(PG8_SA(0, 0), cA, voffA); PG8_STAGE(PG8_SB(0, 1), cB + hstep, voffB); PG8_STAGE(PG8_SA(0, 1), cA + hstep, voffA);
        if (wr == 1) PG8_BAR;
        PG8_WAIT_V(4); PG8_BAR;
        PG8_STAGE(PG8_SB(1, 0), cB + kstep, voffB); PG8_STAGE(PG8_SA(1, 0), cA + kstep, voffA); PG8_STAGE(PG8_SB(1, 1), cB + hstep + kstep, voffB);
        PG8_WAIT_V(6); PG8_BAR;
    }
    for (;;) {
        const bool has_next = S.next(ui + 1, nxt);
        const char* nA = has_next ? (const char*)g.A + (size_t)nxt.pm * tstep : cA; const char* nB = has_next ? (const char*)g.Bt + (size_t)nxt.pn * tstep : cB;
        for (int t = 0; t < nt; t += 2) {
            const bool last = (t == nt - 2);
            const char* a1 = cA + (size_t)(t + 1) * kstep;
            const char* a2 = last ? nA : cA + (size_t)(t + 2) * kstep; const char* b2 = last ? nB : cB + (size_t)(t + 2) * kstep;
            const char* a3 = a2 + kstep; const char* b3 = b2 + kstep;
            if (last && has_next) S.a_ready(nxt);
            if constexpr (SP2) {
            PG8_LDB(B0, 0, 0); PG8_LDB(B1, 0, 1); PG8_SCHED; PG8_LDA(At, 0, 0); PG8_STAGE(PG8_SA(1, 1), a1 + hstep, voffA);
            PG8_WAIT_V(8); PG8_WAIT_L(0); PG8_BAR; PG8_MMA(0, 0, At, B0); PG8_MMA(0, 1, At, B1); PG8_BAR; PG8_SCHED;
            PG8_LDA(At, 0, 1); PG8_STAGE(PG8_SB(0, 0), b2, voffB); PG8_STAGE(PG8_SB(0, 1), b2 + hstep, voffB); PG8_STAGE(PG8_SA(0, 0), a2, voffA);
            PG8_WAIT_V(8); PG8_WAIT_L(0); PG8_BAR; PG8_MMA(1, 0, At, B0); PG8_MMA(1, 1, At, B1); PG8_BAR; PG8_SCHED;
            PG8_LDB(B0, 1, 0); PG8_LDB(B1, 1, 1); PG8_SCHED; PG8_LDA(At, 1, 0); PG8_STAGE(PG8_SA(0, 1), a2 + hstep, voffA);
            PG8_WAIT_V(8); PG8_WAIT_L(0); PG8_BAR; PG8_MMA(0, 0, At, B0); PG8_MMA(0, 1, At, B1); PG8_BAR; PG8_SCHED;
            PG8_LDA(At, 1, 1); PG8_STAGE(PG8_SB(1, 0), b3, voffB); PG8_STAGE(PG8_SB(1, 1), b3 + hstep, voffB); PG8_STAGE(PG8_SA(1, 0), a3, voffA);
            PG8_WAIT_V(8); PG8_WAIT_L(0); PG8_BAR; PG8_MMA(1, 0, At, B0); PG8_MMA(1, 1, At, B1); PG8_BAR; PG8_SCHED;
            } else {
            PG8_LDB(B0, 0, 0); PG8_SCHED; PG8_LDA(At, 0, 0); PG8_STAGE(PG8_SA(1, 1), a1 + hstep, voffA);
            PG8_WAIT_L(8); PG8_BAR; PG8_WAIT_L(0); PG8_MMA(0, 0, At, B0); PG8_BAR; PG8_SCHED;
            PG8_LDB(B1, 0, 1); PG8_STAGE(PG8_SB(0, 0), b2, voffB);
            PG8_BAR; PG8_WAIT_L(0); PG8_MMA(0, 1, At, B1); PG8_BAR;
            PG8_LDA(At, 0, 1); PG8_STAGE(PG8_SA(0, 0), a2, voffA);
            PG8_BAR; PG8_WAIT_L(0); PG8_MMA(1, 0, At, B0); PG8_BAR; PG8_SCHED;
            PG8_STAGE(PG8_SB(0, 1), b2 + hstep, voffB);
            PG8_WAIT_V(6); PG8_BAR; PG8_MMA(1, 1, At, B1); PG8_BAR;
            PG8_LDB(B0, 1, 0); PG8_SCHED; PG8_LDA(At, 1, 0); PG8_STAGE(PG8_SA(0, 1), a2 + hstep, voffA);
            PG8_WAIT_L(8); PG8_BAR; PG8_WAIT_L(0); PG8_MMA(0, 0, At, B0); PG8_BAR; PG8_SCHED;
            PG8_LDB(B1, 1, 1); PG8_STAGE(PG8_SB(1, 0), b3, voffB);
            PG8_BAR; PG8_WAIT_L(0); PG8_MMA(0, 1, At, B1); PG8_BAR;
            PG8_LDA(At, 1, 1); PG8_STAGE(PG8_SA(1, 0), a3, voffA);
            PG8_BAR; PG8_WAIT_L(0); PG8_MMA(1, 0, At, B0); PG8_BAR; PG8_SCHED;
            PG8_STAGE(PG8_SB(1, 1), b3 + hstep, voffB);
            PG8_WAIT_V(6); PG8_BAR; PG8_MMA(1, 1, At, B1); PG8_BAR;
            }
        }
        if constexpr (ALIGN_EPI) { if (wr == 0) PG8_BAR; }
        if constexpr (!Epi::AFTER_DRAIN) { E(acc, cur, wr, wc, fr, fq); S.done(cur); }
        if (!has_next) break;
#pragma unroll
        for (int a = 0; a < 2; ++a)
#pragma unroll
            for (int b = 0; b < 2; ++b)
#pragma unroll
                for (int m = 0; m < 4; ++m)
#pragma unroll
                    for (int n = 0; n < 2; ++n) acc[a][b][m][n] = (f32x4){0.f, 0.f, 0.f, 0.f};
        cur = nxt; cA = nA; cB = nB; ++ui;
        if constexpr (ALIGN_EPI) { if (wr == 1) PG8_BAR; }
    }
    PG8_WAIT_V(0);
    if constexpr (!ALIGN_EPI) { if (wr == 0) PG8_BAR; }
    PG8_BAR;
    if constexpr (Epi::AFTER_DRAIN) { E.fused(acc, cur, wr, wc, fr, fq, lds, wid, lane); S.done(cur); }
#undef PG8_SA
#undef PG8_SB
#undef PG8_STAGE
#undef PG8_LDA
#undef PG8_LDB
#undef PG8_MMA
#undef PG8_WAIT_V
#undef PG8_WAIT_L
#undef PG8_BAR
#undef PG8_SCHED
}
}

constexpr int NWAVES = 8;
constexpr int T = 16384, D = 1024, INW = 5640, N1 = 5632;
constexpr int NPH = 15;
#ifndef MK_PER_PHASE
#define MK_PER_PHASE 0
#endif
constexpr size_t MiB = 1u << 20;
constexpr size_t WS_CTL = 0, CTL_ZERO_BYTES = 1 * MiB;
constexpr size_t WS_WIN = 2 * MiB;
constexpr size_t WS_WUA = 13 * MiB;
constexpr size_t WS_WUM = 14 * MiB;
constexpr size_t WS_WOUT = 15 * MiB;
constexpr size_t WS_WPG = 17 * MiB;
constexpr size_t WS_WPP = 19 * MiB;
constexpr size_t WS_XBARP = 20 * MiB;
constexpr size_t WS_KMEAN = 21 * MiB;
constexpr size_t WS_IF = 21 * MiB + 512 * 1024;
constexpr size_t WS_SEL = 22 * MiB;
constexpr size_t WS_BLAST = 22 * MiB + 512 * 1024;
constexpr size_t WS_MLOC = WS_BLAST + 4096;
constexpr size_t WS_MST = WS_MLOC + 4096;
constexpr size_t WS_NLOC = 23 * MiB;
constexpr size_t WS_NST = 23 * MiB + 256 * 1024;
constexpr size_t WS_PML = 24 * MiB;
constexpr size_t WS_RE = 28 * MiB;
constexpr size_t WS_RW = WS_RE + 128 * 1024;
constexpr size_t WS_TSLOT = WS_RW + 128 * 1024;
constexpr size_t WS_ROWW = WS_TSLOT + 128 * 1024;
constexpr size_t WS_CNT = WS_ROWW + 160 * 1024;
constexpr size_t WS_BLKE = WS_CNT + 32 * 1024;
constexpr size_t WS_PB = 30 * MiB;
constexpr size_t WS_XN = 40 * MiB;
constexpr size_t WS_QC = 40 * MiB, WS_KC = 56 * MiB;
constexpr size_t WS_O7 = 72 * MiB;
constexpr size_t WS_AQ = 72 * MiB, WS_AK = 88 * MiB, WS_AV = 104 * MiB, WS_MQ = 120 * MiB, WS_MK = 136 * MiB, WS_MV = 152 * MiB, WS_MO = 168 * MiB;
constexpr size_t WS_GA = 184 * MiB, WS_GM = 216 * MiB;
constexpr size_t WS_KCT = 248 * MiB, WS_VT = 264 * MiB, WS_AVT = 280 * MiB;
constexpr size_t WS_KVLOC = 120 * MiB;
constexpr size_t WS_CT = 152 * MiB;
constexpr size_t WS_YA = 72 * MiB, WS_YM = 88 * MiB;
constexpr size_t WS_T1 = 120 * MiB, WS_MERGED = 152 * MiB;
constexpr size_t WS_XS = 72 * MiB;
constexpr size_t WS_HID = 152 * MiB;
constexpr size_t WS_YB = 72 * MiB;
constexpr size_t WS_WEUP = 200 * MiB;
constexpr size_t WS_WEDN = 264 * MiB;
constexpr size_t WS_PJ = 152 * MiB;
constexpr size_t WS_END = 296 * MiB;
constexpr int CW_BAR = 4096;
constexpr int CW_QUEUE = 16384;
constexpr int LDS_BYTES = 163840;
constexpr int MISC_OFF = 163840 - 256;

#define GAS __attribute__((address_space(1)))
#define LAS __attribute__((address_space(3)))
typedef unsigned short bf16;
typedef unsigned v4u __attribute__((ext_vector_type(4)));
typedef unsigned v2u __attribute__((ext_vector_type(2)));
typedef float f32x4 __attribute__((ext_vector_type(4)));
typedef float f32x2 __attribute__((ext_vector_type(2)));
typedef short bf16x8 __attribute__((ext_vector_type(8)));
typedef GAS unsigned gu32;
#define RLX_AGENT __ATOMIC_RELAXED, __HIP_MEMORY_SCOPE_AGENT
#define LDS_WAIT() asm volatile("s_waitcnt lgkmcnt(0)" ::: "memory")
#define VM_WAIT() asm volatile("s_waitcnt vmcnt(0)" ::: "memory")
typedef float f32x2_t __attribute__((ext_vector_type(2)));
typedef __bf16 bf16x2_t __attribute__((ext_vector_type(2)));
__device__ __forceinline__ unsigned pk2(float lo, float hi) { const f32x2_t v = {lo, hi}; const bf16x2_t b = __builtin_convertvector(v, bf16x2_t); return __builtin_bit_cast(unsigned, b); }
__device__ __forceinline__ float bflo(unsigned w) { return __uint_as_float(w << 16); }
__device__ __forceinline__ float bfhi(unsigned w) { return __uint_as_float(w & 0xffff0000u); }
__device__ __forceinline__ float sigm(float x) { return __builtin_amdgcn_rcpf(1.0f + __expf(-x)); }
__device__ __forceinline__ float wave_sum(float v) {
#pragma unroll
    for (int o = 1; o < 64; o <<= 1) v += __shfl_xor(v, o);
    return v;
}
__device__ __forceinline__ float wave_max(float v) {
#pragma unroll
    for (int o = 1; o < 64; o <<= 1) v = fmaxf(v, __shfl_xor(v, o));
    return v;
}
#define XB_TMO      128
#define XB_XCNT(j)  (256  + 64 * (j))
#define XB_XSUB(j)  (1280 + 64 * (j))
#define XB_XGEN(j)  (2304 + 64 * (j))
#define XB_TOP      3328
#define XB_TOPGEN   3392
#define XCD_BAR_WORDS 3456
#define XB_SPIN_CAP (1u << 18)

__device__ __forceinline__ unsigned xb_ld(unsigned* p)              { return __hip_atomic_load(p, __ATOMIC_RELAXED, __HIP_MEMORY_SCOPE_AGENT); }
__device__ __forceinline__ unsigned xb_add(unsigned* p, unsigned v) { return __hip_atomic_fetch_add(p, v, __ATOMIC_RELAXED, __HIP_MEMORY_SCOPE_AGENT); }
__device__ __forceinline__ unsigned xb_xcc_id() { return (unsigned)__builtin_amdgcn_s_getreg((3 << 11) | 20) & 0xFu; }
#define XB_SPIN(cond, bar) do { unsigned _sp = 0; while (cond) { __builtin_amdgcn_s_sleep(1); \
    if ((++_sp & 255u) == 0u) { if (xb_ld(&(bar)[XB_TMO])) break; if (_sp > XB_SPIN_CAP) { atomicAdd(&(bar)[XB_TMO], 1u); break; } } } } while (0)

struct XcdBarrier {
    unsigned* bar; unsigned x;
    volatile LAS unsigned* st;
};

__device__ __forceinline__ XcdBarrier xcd_barrier_post(unsigned* bar, volatile LAS unsigned* st) {
    XcdBarrier b; b.bar = bar; b.x = xb_xcc_id(); b.st = st;
    if (threadIdx.x == 0) (void)xb_add(&bar[XB_XCNT(b.x)], 1u);
    return b;
}
__device__ __forceinline__ void xcd_barrier_complete(unsigned* bar, unsigned x, unsigned& nloc, unsigned& nx) {
    const unsigned G = gridDim.x * gridDim.y * gridDim.z;
    unsigned sum, cnt, mine, sp = 0u;
    for (;;) {
        sum = 0u; cnt = 0u; mine = 0u;
#pragma unroll
        for (unsigned j = 0; j < 16; ++j) { const unsigned c = xb_ld(&bar[XB_XCNT(j)]); sum += c; cnt += (c > 0u) ? 1u : 0u; mine = (j == x) ? c : mine; }
        if (sum == G) break;
        __builtin_amdgcn_s_sleep(1);
        if ((++sp & 255u) == 0u) { if (xb_ld(&bar[XB_TMO])) break; if (sp > XB_SPIN_CAP) { atomicAdd(&bar[XB_TMO], 1u); break; } }
    }
    nloc = mine > 0u ? mine : 1u; nx = cnt > 0u ? cnt : 1u;
}

__device__ __forceinline__ void xcd_barrier(const XcdBarrier& b) {
    asm volatile("s_waitcnt vmcnt(0)" ::: "memory");
    __syncthreads();
    if (threadIdx.x == 0) {
        unsigned* bar = b.bar;
        __builtin_amdgcn_s_waitcnt(0);
        unsigned nloc = b.st[0], nx = b.st[1];
        if (nloc == 0u) { xcd_barrier_complete(bar, b.x, nloc, nx); b.st[0] = nloc; b.st[1] = nx; }
        const unsigned old = xb_add(&bar[XB_XSUB(b.x)], 1u);
        const unsigned gen = old / nloc;
        if (old + 1u == (gen + 1u) * nloc) {
            __builtin_amdgcn_fence(__ATOMIC_RELEASE, "agent");
            asm volatile("s_waitcnt vmcnt(0)" ::: "memory");
            const unsigned og = xb_add(&bar[XB_TOP], 1u);
            const unsigned tg = og / nx;
            if (og + 1u == (tg + 1u) * nx) xb_add(&bar[XB_TOPGEN], 1u);
            else XB_SPIN(xb_ld(&bar[XB_TOPGEN]) == tg, bar);
            __builtin_amdgcn_fence(__ATOMIC_ACQUIRE, "agent");
            xb_add(&bar[XB_XGEN(b.x)], 1u);
            asm volatile("s_waitcnt vmcnt(0)" ::: "memory");
        } else {
            XB_SPIN(xb_ld(&bar[XB_XGEN(b.x)]) == gen, bar);
            __builtin_amdgcn_fence(__ATOMIC_ACQUIRE, "agent");
            asm volatile("s_waitcnt vmcnt(0)" ::: "memory");
        }
    }
    __syncthreads();
}

struct Frame {
    LAS unsigned char* lds;
    volatile LAS unsigned* MISC;
    gu32* ctl;
    unsigned char* ws;
    int tid, lane, wave, vcu, G;
    const float* const* in;
    float* out;
};
enum { I_X = 0, I_P, I_MIXG, I_WIN, I_BGATE, I_CONVW, I_CONVB, I_IFB, I_MNG, I_WUA, I_WUM, I_WOUT, I_FFNG, I_RGW, I_RGB, I_REW, I_REB, I_EWG, I_EWU, I_EWD, I_PLEG, I_WPG, I_WPP, I_FING };

__device__ __forceinline__ void transpose_item(const float* W, int ldw, int src_col0, bf16* WT, int K, int dst_row0, LAS float* scr, int kb, int nb, int lane) {
    const int k0 = 64 * kb, n0 = 32 * nb;
#pragma unroll 8
    for (int i = 0; i < 32; ++i) { const int kk = 2 * i + (lane >> 5); scr[kk * 33 + (lane & 31)] = W[(size_t)(k0 + kk) * ldw + src_col0 + n0 + (lane & 31)]; }
    LDS_WAIT(); asm volatile("" ::: "memory");
    const int c = lane & 7;
#pragma unroll
    for (int j = 0; j < 4; ++j) { const int n = (lane >> 3) + 8 * j; const LAS float* s = scr + (8 * c) * 33 + n;
        v4u o; o.x = pk2(s[0 * 33], s[1 * 33]); o.y = pk2(s[2 * 33], s[3 * 33]); o.z = pk2(s[4 * 33], s[5 * 33]); o.w = pk2(s[6 * 33], s[7 * 33]);
        *(GAS v4u*)(WT + (size_t)(dst_row0 + n0 + n) * K + k0 + 8 * c) = o; }
    LDS_WAIT(); asm volatile("" ::: "memory");
}

__device__ __forceinline__ void p0_prologue(Frame& F) {
    if (blockIdx.x == 0 && F.tid < 4) __hip_atomic_store(F.ctl + CW_QUEUE + 64 * F.tid, 0u, RLX_AGENT);
    LAS float* scr = (LAS float*)(F.lds + F.wave * 16384);
    const int gw = F.vcu * NWAVES + F.wave, NGW = F.G * NWAVES;
    constexpr int I_IN = 16 * (N1 / 32), I_UA = 8 * 32, I_UM = 8 * 32, I_OUT = 16 * 32, I_PG = 16 * 32, I_PP = 4 * 32;
    constexpr int NITEMS = I_IN + I_UA + I_UM + I_OUT + I_PG + I_PP;
    for (int it = gw; it < NITEMS; it += NGW) {
        int r = it;
        if (r < I_IN) { const int nb = r % (N1 / 32), kb = r / (N1 / 32); const int sc0 = (nb * 32 >= 3584) ? 8 : 0;
            transpose_item(F.in[I_WIN], INW, sc0, (bf16*)(F.ws + WS_WIN), 1024, 0, scr, kb, nb, F.lane); continue; } r -= I_IN;
        if (r < I_UA) { transpose_item(F.in[I_WUA], 1024, 0, (bf16*)(F.ws + WS_WUA), 512, 0, scr, r / 32, r % 32, F.lane); continue; } r -= I_UA;
        if (r < I_UM) { transpose_item(F.in[I_WUM], 1024, 0, (bf16*)(F.ws + WS_WUM), 512, 0, scr, r / 32, r % 32, F.lane); continue; } r -= I_UM;
        if (r < I_OUT) { transpose_item(F.in[I_WOUT], 1024, 0, (bf16*)(F.ws + WS_WOUT), 1024, 0, scr, r / 32, r % 32, F.lane); continue; } r -= I_OUT;
        if (r < I_PG) { transpose_item(F.in[I_WPG], 1024, 0, (bf16*)(F.ws + WS_WPG), 1024, 0, scr, r / 32, r % 32, F.lane); continue; } r -= I_PG;
        transpose_item(F.in[I_WPP], 1024, 0, (bf16*)(F.ws + WS_WPP), 256, 0, scr, r / 32, r % 32, F.lane);
    }
    __syncthreads();
    LAS float* wif = (LAS float*)F.lds; LAS float* csum = (LAS float*)(F.lds + 32768);
    for (int idx = F.tid; idx < 8192; idx += NWAVES * 64) wif[idx] = F.in[I_WIN][(size_t)(idx >> 3) * INW + 3584 + (idx & 7)];
    __syncthreads();
    const float* x = F.in[I_X]; const float* gain = F.in[I_MIXG]; bf16* XN = (bf16*)(F.ws + WS_XN); float* IFB = (float*)(F.ws + WS_IF);
    f32x4 gv[4], cs[4];
#pragma unroll
    for (int j = 0; j < 4; ++j) { gv[j] = *(const f32x4*)(gain + 4 * F.lane + 256 * j); cs[j] = (f32x4){0.f, 0.f, 0.f, 0.f}; }
    for (int i = 0; i < 8; ++i) {
        const int row = 64 * F.vcu + 8 * F.wave + i;
        const GAS f32x4* xr = (const GAS f32x4*)(x + (size_t)row * D) + F.lane;
        f32x4 v[4]; float ss = 0.f;
#pragma unroll
        for (int j = 0; j < 4; ++j) { v[j] = xr[64 * j]; ss += (v[j].x * v[j].x + v[j].y * v[j].y) + (v[j].z * v[j].z + v[j].w * v[j].w); }
        const float rs = 1.0f / sqrtf(wave_sum(ss) * (1.f / D) + 1e-6f);
        GAS unsigned long long* o8 = (GAS unsigned long long*)(XN + (size_t)row * D) + F.lane;
        float dt[8];
#pragma unroll
        for (int c = 0; c < 8; ++c) dt[c] = 0.f;
#pragma unroll
        for (int j = 0; j < 4; ++j) { v[j] = v[j] * rs * gv[j]; cs[j] += v[j];
            o8[64 * j] = (unsigned long long)pk2(v[j].x, v[j].y) | ((unsigned long long)pk2(v[j].z, v[j].w) << 32);
#pragma unroll
            for (int e = 0; e < 4; ++e) { const LAS f32x4* wp = (const LAS f32x4*)(wif + (4 * F.lane + 256 * j + e) * 8); const f32x4 w0 = wp[0], w1 = wp[1];
                dt[0] += v[j][e] * w0.x; dt[1] += v[j][e] * w0.y; dt[2] += v[j][e] * w0.z; dt[3] += v[j][e] * w0.w; dt[4] += v[j][e] * w1.x; dt[5] += v[j][e] * w1.y; dt[6] += v[j][e] * w1.z; dt[7] += v[j][e] * w1.w; } }
#pragma unroll
        for (int c = 0; c < 8; ++c) dt[c] = wave_sum(dt[c]);
        if (F.lane == 0) { const float* ifb = F.in[I_IFB];
            *(f32x4*)(IFB + (size_t)row * 8) = (f32x4){dt[0] + ifb[0], dt[1] + ifb[1], dt[2] + ifb[2], dt[3] + ifb[3]};
            *(f32x4*)(IFB + (size_t)row * 8 + 4) = (f32x4){dt[4] + ifb[4], dt[5] + ifb[5], dt[6] + ifb[6], dt[7] + ifb[7]}; }
        { const f32x4 pv = *((const GAS f32x4*)(F.in[I_P] + (size_t)row * 256) + F.lane);
          *((GAS unsigned long long*)((bf16*)(F.ws + WS_PB) + (size_t)row * 256) + F.lane) = (unsigned long long)pk2(pv.x, pv.y) | ((unsigned long long)pk2(pv.z, pv.w) << 32); }
    }
#pragma unroll
    for (int j = 0; j < 4; ++j) *(LAS f32x4*)(csum + F.wave * 1024 + 4 * F.lane + 256 * j) = cs[j];
    __syncthreads();
    for (int c = F.tid; c < 1024; c += NWAVES * 64) { float s = 0.f;
#pragma unroll
        for (int w = 0; w < 8; ++w) s += csum[w * 1024 + c];
        ((float*)(F.ws + WS_XBARP))[(size_t)F.vcu * 1024 + c] = s; }
    __syncthreads();
}

__device__ __forceinline__ void p1_kmean(Frame& F) {
    LAS float* xb = (LAS float*)F.lds; LAS float* part = (LAS float*)(F.lds + 4096);
    const int j = F.vcu >> 2, c0 = (F.vcu & 3) * 128; const float* XP = (const float*)(F.ws + WS_XBARP);
    for (int k = F.tid; k < 1024; k += NWAVES * 64) xb[k] = (XP[(size_t)(4 * j) * 1024 + k] + XP[(size_t)(4 * j + 1) * 1024 + k] + XP[(size_t)(4 * j + 2) * 1024 + k] + XP[(size_t)(4 * j + 3) * 1024 + k]) * (1.0f / 256.0f);
    __syncthreads();
    const int col = c0 + (F.tid & 127), pt = F.tid >> 7; const float* wp = F.in[I_WIN] + 512 + col; float s = 0.f;
    for (int k = pt * 256; k < pt * 256 + 256; ++k) s += xb[k] * wp[(size_t)k * INW];
    part[pt * 128 + (F.tid & 127)] = s;
    __syncthreads();
    if (F.tid < 128) { const float r = part[F.tid] + part[128 + F.tid] + part[256 + F.tid] + part[384 + F.tid]; ((float*)(F.ws + WS_KMEAN))[((col >> 6) * 64 + j) * 64 + (col & 63)] = r; }
    __syncthreads();
}

__device__ __forceinline__ float bfe(const v4u& q, int e) { const unsigned w = q[e >> 1]; return (e & 1) ? bfhi(w) : bflo(w); }
__device__ __forceinline__ void layout_tile(Frame& F, int kind, int tt, int cc) {
    const int r8 = F.lane >> 3, ch = F.lane & 7, c0 = cc * 64 + ch * 8, t0 = tt * 64 + r8 * 8;
    const bf16* src = (const bf16*)(F.ws + (kind == 0 ? WS_MQ : kind == 1 ? WS_MK : kind == 2 ? WS_MV : WS_AV));
    float v[8][8];
    if (kind < 2) {
        const float* cw = F.in[I_CONVW] + (kind == 1 ? 512 : 0) + c0; const float* cb = F.in[I_CONVB] + (kind == 1 ? 512 : 0) + c0;
        float w[4][8], b[8];
#pragma unroll
        for (int k = 0; k < 4; ++k) { const f32x4 a = *(const f32x4*)(cw + k * 1024), c = *(const f32x4*)(cw + k * 1024 + 4); w[k][0] = a.x; w[k][1] = a.y; w[k][2] = a.z; w[k][3] = a.w; w[k][4] = c.x; w[k][5] = c.y; w[k][6] = c.z; w[k][7] = c.w; }
        { const f32x4 a = *(const f32x4*)cb, c = *(const f32x4*)(cb + 4); b[0] = a.x; b[1] = a.y; b[2] = a.z; b[3] = a.w; b[4] = c.x; b[5] = c.y; b[6] = c.z; b[7] = c.w; }
        v4u xp[11];
#pragma unroll
        for (int i = 0; i < 11; ++i) { const int t = t0 - 3 + i; xp[i] = (v4u){0u, 0u, 0u, 0u}; if (t >= 0) xp[i] = *(const GAS v4u*)(src + (size_t)t * 512 + c0); }
        const float osc = kind == 1 ? 0.08838834764831845f : 1.0f;
#pragma unroll
        for (int i = 0; i < 8; ++i)
#pragma unroll
            for (int e = 0; e < 8; ++e) { const float y = b[e] + w[0][e] * bfe(xp[i], e) + w[1][e] * bfe(xp[i + 1], e) + w[2][e] * bfe(xp[i + 2], e) + w[3][e] * bfe(xp[i + 3], e); v[i][e] = y * sigm(y) * osc; }
        bf16* dst = (bf16*)(F.ws + (kind == 0 ? WS_QC : WS_KC));
#pragma unroll
        for (int i = 0; i < 8; ++i) { v4u o; o.x = pk2(v[i][0], v[i][1]); o.y = pk2(v[i][2], v[i][3]); o.z = pk2(v[i][4], v[i][5]); o.w = pk2(v[i][6], v[i][7]); *(GAS v4u*)(dst + (size_t)(t0 + i) * 512 + c0) = o; }
    } else {
#pragma unroll
        for (int i = 0; i < 8; ++i) { const v4u q = *(const GAS v4u*)(src + (size_t)(t0 + i) * 512 + c0);
            v[i][0] = bflo(q.x); v[i][1] = bfhi(q.x); v[i][2] = bflo(q.y); v[i][3] = bfhi(q.y); v[i][4] = bflo(q.z); v[i][5] = bfhi(q.z); v[i][6] = bflo(q.w); v[i][7] = bfhi(q.w); }
    }
    if (kind >= 1) {
        bf16* dt = (bf16*)(F.ws + (kind == 1 ? WS_KCT : kind == 2 ? WS_VT : WS_AVT));
#pragma unroll
        for (int e = 0; e < 8; ++e) { v4u o; o.x = pk2(v[0][e], v[1][e]); o.y = pk2(v[2][e], v[3][e]); o.z = pk2(v[4][e], v[5][e]); o.w = pk2(v[6][e], v[7][e]); *(GAS v4u*)(dt + (size_t)(c0 + e) * T + t0) = o; }
    }
}
__device__ __forceinline__ void p2_layout_select(Frame& F) {
    const int gw = F.vcu * NWAVES + F.wave;
    { const int tt = gw >> 3, cc = gw & 7; layout_tile(F, 0, tt, cc); layout_tile(F, 1, tt, cc); layout_tile(F, 2, tt, cc); layout_tile(F, 3, tt, cc); }
    const int h = F.wave, t = 64 * F.vcu + F.lane, cur = (64 * F.vcu) >> 8;
    float q[64];
    { const GAS v4u* qp = (const GAS v4u*)((const bf16*)(F.ws + WS_AQ) + (size_t)t * 512 + h * 64);
#pragma unroll
      for (int i = 0; i < 8; ++i) { const v4u w = qp[i]; q[8 * i] = bflo(w.x); q[8 * i + 1] = bfhi(w.x); q[8 * i + 2] = bflo(w.y); q[8 * i + 3] = bfhi(w.y); q[8 * i + 4] = bflo(w.z); q[8 * i + 5] = bfhi(w.z); q[8 * i + 6] = bflo(w.w); q[8 * i + 7] = bfhi(w.w); } }
    float b0 = -INFINITY, b1 = -INFINITY, b2 = -INFINITY; int i0 = 255, i1 = 255, i2 = 255;
    const float* km = (const float*)(F.ws + WS_KMEAN) + (size_t)h * 64 * 64;
    for (int j = 0; j < cur; ++j) { const float* kj = km + j * 64; float s = 0.f;
#pragma unroll
        for (int d = 0; d < 64; ++d) s += q[d] * kj[d];
        if (s > b0) { b2 = b1; i2 = i1; b1 = b0; i1 = i0; b0 = s; i0 = j; } else if (s > b1) { b2 = b1; i2 = i1; b1 = s; i1 = j; } else if (s > b2) { b2 = s; i2 = j; } }
    ((unsigned*)(F.ws + WS_SEL))[(size_t)t * 8 + h] = (unsigned)i0 | ((unsigned)i1 << 8) | ((unsigned)i2 << 16);
}

constexpr int A_KS = 0, A_KROW = 144, A_VS = 36864, A_VROW = 528, A_LIST = 70656, A_MLS = 81920;
constexpr float LOG2E = 1.4426950408889634f;
#define MFMA16(a, b, c) __builtin_amdgcn_mfma_f32_16x16x32_bf16((a), (b), (c), 0, 0, 0)

__device__ __forceinline__ void attn_stage_kv(Frame& F, int h, int kbase) {
    const bf16* AK = (const bf16*)(F.ws + WS_AK); const bf16* AVT = (const bf16*)(F.ws + WS_AVT);
#pragma unroll
    for (int p = 0; p < 4; ++p) { const int idx = F.tid + 512 * p, row = idx >> 3, chk = idx & 7;
        *(LAS v4u*)(F.lds + A_KS + row * A_KROW + chk * 16) = *(const GAS v4u*)(AK + (size_t)(kbase + row) * 512 + h * 64 + chk * 8); }
#pragma unroll
    for (int p = 0; p < 4; ++p) { const int idx = F.tid + 512 * p, d = idx >> 5, chk = idx & 31;
        *(LAS v4u*)(F.lds + A_VS + d * A_VROW + chk * 16) = *(const GAS v4u*)(AVT + (size_t)(h * 64 + d) * T + kbase + chk * 8); }
}
template <bool CAUSAL> __device__ __forceinline__ void attn_tile(Frame& F, int h, int tq, int nkt, int qrel, bool valid, int slot) {
    const int fr = F.lane & 15, g = F.lane >> 4;
    const bf16* AQ = (const bf16*)(F.ws + WS_AQ);
    bf16x8 qf[2];
#pragma unroll
    for (int kk = 0; kk < 2; ++kk) qf[kk] = *(const GAS bf16x8*)(AQ + (size_t)tq * 512 + h * 64 + kk * 32 + g * 8);
    f32x4 s[16];
#pragma unroll
    for (int kt = 0; kt < 16; ++kt) {
        if (kt < nkt) {
            const LAS unsigned char* kp = F.lds + A_KS + (16 * kt + fr) * A_KROW + g * 16;
            const bf16x8 a0 = *(const LAS bf16x8*)kp, a1 = *(const LAS bf16x8*)(kp + 64);
            f32x4 c = (f32x4){0.f, 0.f, 0.f, 0.f}; c = MFMA16(a0, qf[0], c); c = MFMA16(a1, qf[1], c);
            if (CAUSAL) {
#pragma unroll
                for (int r = 0; r < 4; ++r) if (16 * kt + 4 * g + r > qrel) c[r] = -INFINITY;
            }
            s[kt] = c;
        } else s[kt] = (f32x4){-INFINITY, -INFINITY, -INFINITY, -INFINITY};
        if ((kt & 3) == 3) asm volatile("" ::: "memory");
    }
    float mx = -INFINITY;
#pragma unroll
    for (int kt = 0; kt < 16; ++kt) mx = fmaxf(fmaxf(fmaxf(s[kt][0], s[kt][1]), fmaxf(s[kt][2], s[kt][3])), mx);
    mx = fmaxf(mx, __shfl_xor(mx, 16)); mx = fmaxf(mx, __shfl_xor(mx, 32));
    float l = 0.f; bf16x8 pb[8];
#pragma unroll
    for (int i = 0; i < 8; ++i) {
        f32x4 p0, p1;
#pragma unroll
        for (int r = 0; r < 4; ++r) { p0[r] = __builtin_amdgcn_exp2f((s[2 * i][r] - mx) * LOG2E); p1[r] = __builtin_amdgcn_exp2f((s[2 * i + 1][r] - mx) * LOG2E); }
        l += (p0[0] + p0[1]) + (p0[2] + p0[3]) + (p1[0] + p1[1]) + (p1[2] + p1[3]);
        v4u w; w.x = pk2(p0[0], p0[1]); w.y = pk2(p0[2], p0[3]); w.z = pk2(p1[0], p1[1]); w.w = pk2(p1[2], p1[3]);
        pb[i] = __builtin_bit_cast(bf16x8, w);
    }
    l += __shfl_xor(l, 16); l += __shfl_xor(l, 32);
    f32x4 o[4];
#pragma unroll
    for (int dt = 0; dt < 4; ++dt) o[dt] = (f32x4){0.f, 0.f, 0.f, 0.f};
#pragma unroll
    for (int i = 0; i < 8; ++i) {
        if (2 * i < nkt) {
#pragma unroll
            for (int dt = 0; dt < 4; ++dt) {
                const LAS unsigned char* vp = F.lds + A_VS + (16 * dt + fr) * A_VROW + (32 * i + 4 * g) * 2;
                const v2u lo = *(const LAS v2u*)vp, hi = *(const LAS v2u*)(vp + 32);
                const v4u vv = (v4u){lo.x, lo.y, hi.x, hi.y};
                o[dt] = MFMA16(__builtin_bit_cast(bf16x8, vv), pb[i], o[dt]);
            }
        }
        if (i & 1) asm volatile("" ::: "memory");
    }
    if (valid) {
        bf16* PO = (bf16*)F.out + ((size_t)(tq * 8 + h) * 4 + slot) * 64;
#pragma unroll
        for (int dt = 0; dt < 4; ++dt) { v2u w; w.x = pk2(o[dt][0], o[dt][1]); w.y = pk2(o[dt][2], o[dt][3]); *(GAS v2u*)(PO + 16 * dt + 4 * g) = w; }
        if (g == 0) *(GAS f32x2*)((float*)(F.ws + WS_PML) + ((size_t)(tq * 8 + h) * 4 + slot) * 2) = (f32x2){mx, l};
    }
}
__device__ __forceinline__ void attn_gather_item(Frame& F, int h, int j) {
    attn_stage_kv(F, h, j * 256);
    LAS unsigned* LIST = (LAS unsigned*)(F.lds + A_LIST); LAS unsigned* cnt = (LAS unsigned*)(F.MISC + 17);
    if (F.tid == 0) *cnt = 0u;
    __syncthreads();
    const unsigned* SEL = (const unsigned*)(F.ws + WS_SEL);
    for (int base = 256 * (j + 1); base < T; base += 2048) {
#pragma unroll
        for (int k = 0; k < 4; ++k) { const int t = base + k * 512 + F.tid;
            if (t < T) { const unsigned w = SEL[(size_t)t * 8 + h]; const int slot = ((w & 255u) == (unsigned)j) ? 0 : (((w >> 8) & 255u) == (unsigned)j) ? 1 : (((w >> 16) & 255u) == (unsigned)j) ? 2 : -1;
                if (slot >= 0) { const unsigned pos = __hip_atomic_fetch_add(cnt, 1u, __ATOMIC_RELAXED, __HIP_MEMORY_SCOPE_WORKGROUP); LIST[pos] = (unsigned)t | ((unsigned)slot << 16); } } }
        __syncthreads();
        const int n = __builtin_amdgcn_readfirstlane((int)*cnt); const bool last = (base + 2048 >= T); const int ntile = last ? (n + 127) >> 7 : n >> 7;
        for (int tile = 0; tile < ntile; ++tile) {
            if (tile * 128 + F.wave * 16 >= n) continue;
            const int idx = tile * 128 + F.wave * 16 + (F.lane & 15); const bool valid = idx < n; const unsigned e = LIST[valid ? idx : tile * 128 + F.wave * 16];
            attn_tile<false>(F, h, (int)(e & 0xffffu), 16, 0, valid, (int)(e >> 16));
        }
        __syncthreads();
        const int rem = last ? 0 : n - ntile * 128; unsigned keep = 0u; if (F.tid < rem) keep = LIST[ntile * 128 + F.tid];
        __syncthreads();
        if (F.tid < rem) LIST[F.tid] = keep; if (F.tid == 0) *cnt = (unsigned)rem;
        __syncthreads();
    }
}
__device__ __forceinline__ void attn_diag_item(Frame& F, int h, int blk) {
    attn_stage_kv(F, h, blk * 256);
    __syncthreads();
#pragma unroll 1
    for (int qt = 0; qt < 2; ++qt) { const int qrel = qt * 128 + F.wave * 16 + (F.lane & 15); attn_tile<true>(F, h, blk * 256 + qrel, qt ? 16 : 8, qrel, true, 3); }
    __syncthreads();
}
__device__ __forceinline__ float wave_scan_add(float v, int lane) {
#pragma unroll
    for (int o = 1; o < 64; o <<= 1) { const float y = __shfl_up(v, o); if (lane >= o) v += y; }
    return v;
}
__device__ __forceinline__ float wave_scan_max(float v, int lane) {
#pragma unroll
    for (int o = 1; o < 64; o <<= 1) { const float y = __shfl_up(v, o); if (lane >= o) v = fmaxf(v, y); }
    return v;
}
__device__ __forceinline__ float log_sigmoid(float x) { return fminf(x, 0.f) - log1pf(__expf(-fabsf(x))); }
__device__ __forceinline__ void mlstm_local_item(Frame& F, int h, int c) {
    const int t0 = c * 128, fr = F.lane & 15, g = F.lane >> 4, w = F.wave;
    const float* IFB = (const float*)(F.ws + WS_IF);
    const float li0 = IFB[(size_t)(t0 + 2 * F.lane) * 8 + h], li1 = IFB[(size_t)(t0 + 2 * F.lane + 1) * 8 + h];
    const float lf0 = log_sigmoid(IFB[(size_t)(t0 + 2 * F.lane) * 8 + 4 + h]), lf1 = log_sigmoid(IFB[(size_t)(t0 + 2 * F.lane + 1) * 8 + 4 + h]);
    const float P = wave_scan_add(lf0 + lf1, F.lane), bc1 = P, bc0 = P - lf1, blast = __shfl(P, 63);
    const float a0 = li0 - bc0, a1 = li1 - bc1, amax = wave_max(fmaxf(a0, a1));
    LAS float* wtab = (LAS float*)(F.lds + A_MLS + w * 2048);
    *(LAS f32x2*)(wtab + 2 * F.lane) = (f32x2){__expf(a0 - amax), __expf(a1 - amax)};
    LDS_WAIT(); asm volatile("" ::: "memory");
    const bf16* KCT = (const bf16*)(F.ws + WS_KCT); const bf16* VT = (const bf16*)(F.ws + WS_VT);
    f32x4 acc[8];
#pragma unroll
    for (int et = 0; et < 8; ++et) acc[et] = (f32x4){0.f, 0.f, 0.f, 0.f};
    float nsum = 0.f;
#pragma unroll
    for (int kk = 0; kk < 4; ++kk) {
        const v4u kc = *(const GAS v4u*)(KCT + (size_t)(h * 128 + 16 * w + fr) * T + t0 + 32 * kk + 8 * g);
        const f32x4 w0 = *(const LAS f32x4*)(wtab + 32 * kk + 8 * g), w1 = *(const LAS f32x4*)(wtab + 32 * kk + 8 * g + 4);
        const float k0 = bflo(kc.x) * w0.x, k1 = bfhi(kc.x) * w0.y, k2 = bflo(kc.y) * w0.z, k3 = bfhi(kc.y) * w0.w, k4 = bflo(kc.z) * w1.x, k5 = bfhi(kc.z) * w1.y, k6 = bflo(kc.w) * w1.z, k7 = bfhi(kc.w) * w1.w;
        nsum += ((k0 + k1) + (k2 + k3)) + ((k4 + k5) + (k6 + k7));
        v4u ap; ap.x = pk2(k0, k1); ap.y = pk2(k2, k3); ap.z = pk2(k4, k5); ap.w = pk2(k6, k7);
        const bf16x8 af = __builtin_bit_cast(bf16x8, ap);
#pragma unroll
        for (int et = 0; et < 8; ++et) { const bf16x8 bfv = *(const GAS bf16x8*)(VT + (size_t)(h * 128 + 16 * et + fr) * T + t0 + 32 * kk + 8 * g); acc[et] = MFMA16(af, bfv, acc[et]); }
    }
    float* KV = (float*)(F.ws + WS_KVLOC) + (size_t)(h * 128 + c) * 16384;
#pragma unroll
    for (int et = 0; et < 8; ++et) *(GAS f32x4*)(KV + (size_t)(16 * et + fr) * 128 + 16 * w + 4 * g) = acc[et];
    nsum += __shfl_xor(nsum, 16); nsum += __shfl_xor(nsum, 32);
    if (g == 0) ((float*)(F.ws + WS_NLOC))[(size_t)(h * 128 + c) * 128 + 16 * w + fr] = nsum;
    if (F.tid == 0) { ((float*)(F.ws + WS_BLAST))[h * 128 + c] = blast; ((float*)(F.ws + WS_MLOC))[h * 128 + c] = blast + amax; }
}
__device__ __forceinline__ int queue_pop(Frame& F, int q) {
    if (F.tid == 0) F.MISC[16] = __hip_atomic_fetch_add(F.ctl + CW_QUEUE + 64 * q, 1u, RLX_AGENT);
    __syncthreads();
    const int item = __builtin_amdgcn_readfirstlane((int)F.MISC[16]);
    __syncthreads();
    return item;
}
__device__ __forceinline__ void p3_attention(Frame& F) {
    constexpr int N_G = 63 * 8, N_D = 64 * 8;
#ifndef MK_P3
#define MK_P3 7
#endif
    if (MK_P3 & 1) {
#pragma unroll 1
        for (int item = queue_pop(F, 0); (unsigned)item < (unsigned)N_G; item = queue_pop(F, 0)) attn_gather_item(F, item & 7, item >> 3);
    }
    if (MK_P3 & 2) {
#pragma unroll 1
        for (int item = queue_pop(F, 1); (unsigned)item < (unsigned)N_D; item = queue_pop(F, 1)) attn_diag_item(F, item & 7, item >> 3);
    }
    if (MK_P3 & 4) {
#pragma unroll 1
        for (int k = 0; k < 2; ++k) { const int item = F.vcu * 2 + k; mlstm_local_item(F, item & 3, item >> 2); }
    }
}


#if defined(MK_DEBUG)
__device__ __forceinline__ void dbg_fill_sentinel(Frame& F) {
    float* PML = (float*)(F.ws + WS_PML) + (size_t)(64 * F.vcu) * 64;
    for (int i = F.tid; i < 4096; i += NWAVES * 64) PML[i] = 12345.0f;
}
__device__ __forceinline__ void dbg_check(Frame& F) {
    const float* PML = (const float*)(F.ws + WS_PML); const bf16* PO = (const bf16*)F.out;
    unsigned lost = 0, bad = 0;
    for (int i = F.tid; i < 64 * 8 * 4; i += NWAVES * 64) { const int tl = i >> 5, h = (i >> 2) & 7, k = i & 3, t = 64 * F.vcu + tl, cur = t >> 8, nv = cur < 3 ? cur : 3;
        if (k == 3 || k < nv) { const float m = PML[((size_t)(t * 8 + h) * 4 + k) * 2], l = PML[((size_t)(t * 8 + h) * 4 + k) * 2 + 1];
            if (m == 12345.0f) lost++; else { bool ok = (m == m) && (l == l) && fabsf(m) < 1e30f && l > 0.f && l < 1e30f;
                for (int d = 0; d < 64; ++d) { const float o = __uint_as_float((unsigned)PO[((size_t)(t * 8 + h) * 4 + k) * 64 + d] << 16); ok = ok && (o == o) && fabsf(o) < 1e30f; }
                if (!ok) bad++; } } }
    if (lost) __hip_atomic_fetch_add(F.ctl + CW_QUEUE + 64 * 4, lost, RLX_AGENT);
    if (bad) __hip_atomic_fetch_add(F.ctl + CW_QUEUE + 64 * 5, bad, RLX_AGENT);
}
__device__ __forceinline__ void dbg_report(Frame& F) {
    const unsigned lost = __hip_atomic_load(F.ctl + CW_QUEUE + 64 * 4, RLX_AGENT), bad = __hip_atomic_load(F.ctl + CW_QUEUE + 64 * 5, RLX_AGENT);
    const float v = 100.0f + (lost ? 1000.0f : 0.f) + (bad ? 30000.0f : 0.f) + (lost > 1000u ? 200.f : 0.f) + (bad > 1000u ? 5000.f : 0.f);
    for (int i = F.tid; i < 64 * 1024; i += NWAVES * 64) F.out[(size_t)(64 * F.vcu) * 1024 + i] = v;
}
#endif

#if defined(MK_DUMP)
__device__ __forceinline__ void dbg_dump_bf16(Frame& F, size_t ws_off, int ld, int ncols) {
    const bf16* src = (const bf16*)(F.ws + ws_off);
    for (int i = F.tid; i < 64 * 1024; i += NWAVES * 64) { const int t = 64 * F.vcu + (i >> 10), c = i & 1023; F.out[(size_t)t * 1024 + c] = c < ncols ? __uint_as_float((unsigned)src[(size_t)t * ld + c] << 16) : 0.f; }
}
#endif
__device__ __forceinline__ void p4_scan_combine(Frame& F) {
    if (F.vcu < 132) {
        const int h = F.vcu < 128 ? (F.vcu >> 5) : (F.vcu - 128);
        LAS float* dec = (LAS float*)F.lds; LAS float* scl = (LAS float*)(F.lds + 512);
        if (F.tid == 0) { const float* BL = (const float*)(F.ws + WS_BLAST) + h * 128; const float* ML = (const float*)(F.ws + WS_MLOC) + h * 128; float* MS = (float*)(F.ws + WS_MST) + h * 128;
            float m = 0.f;
            for (int c = 0; c < 128; ++c) { if ((F.vcu & 31) == 0 && F.vcu < 128) MS[c] = m; const float bl = BL[c], ml = ML[c], mn = fmaxf(bl + m, ml); dec[c] = __expf(bl + m - mn); scl[c] = __expf(ml - mn); m = mn; } }
        __syncthreads();
        if (F.vcu < 128) {
            const int e = 4 * (F.vcu & 31) + (F.tid >> 7), d = F.tid & 127;
            const float* KV = (const float*)(F.ws + WS_KVLOC) + (size_t)h * 128 * 16384 + e * 128 + d; bf16* CT = (bf16*)(F.ws + WS_CT) + (size_t)h * 128 * 16384 + e * 128 + d;
            float C = 0.f;
#pragma unroll 8
            for (int c = 0; c < 128; ++c) { const float kv = KV[(size_t)c * 16384]; CT[(size_t)c * 16384] = (bf16)(pk2(C, 0.f) & 0xffffu); C = dec[c] * C + scl[c] * kv; }
        } else if (F.tid < 128) {
            const float* NL = (const float*)(F.ws + WS_NLOC) + (size_t)h * 16384 + F.tid; float* NS = (float*)(F.ws + WS_NST) + (size_t)h * 16384 + F.tid;
            float n = 0.f;
#pragma unroll 8
            for (int c = 0; c < 128; ++c) { const float nl = NL[c * 128]; NS[c * 128] = n; n = dec[c] * n + scl[c] * nl; }
        }
        __syncthreads();
    }
    const int gw = F.vcu * NWAVES + F.wave; const int h = F.lane >> 3, d8 = (F.lane & 7) * 8;
    const float* PML = (const float*)(F.ws + WS_PML); const bf16* PO = (const bf16*)F.out; bf16* YA = (bf16*)(F.ws + WS_YA);
    for (int i = 0; i < 8; ++i) {
        const int t = gw * 8 + i, cur = t >> 8, nv = cur < 3 ? cur : 3;
        float m[4], l[4]; float M = -INFINITY;
#pragma unroll
        for (int k = 0; k < 4; ++k) { const bool ok = (k == 3) || (k < nv); m[k] = -INFINITY; l[k] = 0.f;
            if (ok) { const f32x2 ml = *(const GAS f32x2*)(PML + ((size_t)(t * 8 + h) * 4 + k) * 2); m[k] = ml.x; l[k] = ml.y; } M = fmaxf(M, m[k]); }
        float o[8]; float L = 0.f;
#pragma unroll
        for (int e = 0; e < 8; ++e) o[e] = 0.f;
#pragma unroll
        for (int k = 0; k < 4; ++k) { const bool ok = (k == 3) || (k < nv);
            if (ok) { const float wk = __builtin_amdgcn_exp2f((m[k] - M) * LOG2E); L += wk * l[k]; const v4u q = *(const GAS v4u*)(PO + ((size_t)(t * 8 + h) * 4 + k) * 64 + d8);
                o[0] += wk * bflo(q.x); o[1] += wk * bfhi(q.x); o[2] += wk * bflo(q.y); o[3] += wk * bfhi(q.y); o[4] += wk * bflo(q.z); o[5] += wk * bfhi(q.z); o[6] += wk * bflo(q.w); o[7] += wk * bfhi(q.w); } }
        const float inv = 1.0f / L; v4u r; r.x = pk2(o[0] * inv, o[1] * inv); r.y = pk2(o[2] * inv, o[3] * inv); r.z = pk2(o[4] * inv, o[5] * inv); r.w = pk2(o[6] * inv, o[7] * inv);
        *(GAS v4u*)(YA + (size_t)t * 512 + h * 64 + d8) = r;
    }
}

__device__ __forceinline__ void mlstm_out_item(Frame& F, int h, int c) {
    const int t0 = c * 128, fr = F.lane & 15, g = F.lane >> 4, w = F.wave;
    const float* IFB = (const float*)(F.ws + WS_IF);
    const float li0 = IFB[(size_t)(t0 + 2 * F.lane) * 8 + h], li1 = IFB[(size_t)(t0 + 2 * F.lane + 1) * 8 + h];
    const float lf0 = log_sigmoid(IFB[(size_t)(t0 + 2 * F.lane) * 8 + 4 + h]), lf1 = log_sigmoid(IFB[(size_t)(t0 + 2 * F.lane + 1) * 8 + 4 + h]);
    const float P = wave_scan_add(lf0 + lf1, F.lane), bc1 = P, bc0 = P - lf1;
    const float a0 = li0 - bc0, a1 = li1 - bc1;
    const float PM = wave_scan_max(fmaxf(a0, a1), F.lane); float ex = __shfl_up(PM, 1); if (F.lane == 0) ex = -INFINITY;
    const float pm0 = fmaxf(ex, a0), pm1 = PM;
    LAS float* atab = (LAS float*)(F.lds + A_MLS + w * 2048); LAS float* btab = atab + 128; LAS float* ptab = atab + 256;
    *(LAS f32x2*)(atab + 2 * F.lane) = (f32x2){a0, a1}; *(LAS f32x2*)(btab + 2 * F.lane) = (f32x2){bc0, bc1}; *(LAS f32x2*)(ptab + 2 * F.lane) = (f32x2){pm0, pm1};
    LDS_WAIT(); asm volatile("" ::: "memory");
    const int tl = 16 * w + fr;
    const float mcar = ((const float*)(F.ws + WS_MST))[h * 128 + c];
    const float bt = btab[tl], inter = bt + mcar, mt = fmaxf(inter, bt + ptab[tl]), sci = __expf(inter - mt), ct = bt - mt;
    const bf16* QC = (const bf16*)(F.ws + WS_QC); const bf16* KC = (const bf16*)(F.ws + WS_KC); const bf16* VT = (const bf16*)(F.ws + WS_VT); const bf16* CT = (const bf16*)(F.ws + WS_CT) + (size_t)(h * 128 + c) * 16384;
    bf16x8 qf[4];
#pragma unroll
    for (int kk = 0; kk < 4; ++kk) qf[kk] = *(const GAS bf16x8*)(QC + (size_t)(t0 + tl) * 512 + h * 128 + 32 * kk + 8 * g);
    float qn = 0.f; { const float* NS = (const float*)(F.ws + WS_NST) + (size_t)(h * 128 + c) * 128;
#pragma unroll
        for (int kk = 0; kk < 4; ++kk) { const v4u q = __builtin_bit_cast(v4u, qf[kk]); const f32x4 n0 = *(const GAS f32x4*)(NS + 32 * kk + 8 * g), n1 = *(const GAS f32x4*)(NS + 32 * kk + 8 * g + 4);
            qn += bflo(q.x) * n0.x + bfhi(q.x) * n0.y + bflo(q.y) * n0.z + bfhi(q.y) * n0.w + bflo(q.z) * n1.x + bfhi(q.z) * n1.y + bflo(q.w) * n1.z + bfhi(q.w) * n1.w; } }
    qn += __shfl_xor(qn, 16); qn += __shfl_xor(qn, 32);
    float dsum = 0.f; v2u pw[8];
#pragma unroll
    for (int st = 0; st < 8; ++st) {
        pw[st] = (v2u){0u, 0u};
        if (st <= w) {
            f32x4 s = (f32x4){0.f, 0.f, 0.f, 0.f};
#pragma unroll
            for (int kk = 0; kk < 4; ++kk) { const bf16x8 kf = *(const GAS bf16x8*)(KC + (size_t)(t0 + 16 * st + fr) * 512 + h * 128 + 32 * kk + 8 * g); s = MFMA16(kf, qf[kk], s); }
            const f32x4 av = *(const LAS f32x4*)(atab + 16 * st + 4 * g);
#pragma unroll
            for (int r = 0; r < 4; ++r) { const float wgt = (16 * st + 4 * g + r <= tl) ? __expf(av[r] + ct) : 0.f; s[r] *= wgt; }
            dsum += (s[0] + s[1]) + (s[2] + s[3]);
            pw[st].x = pk2(s[0], s[1]); pw[st].y = pk2(s[2], s[3]);
        }
    }
    dsum += __shfl_xor(dsum, 16); dsum += __shfl_xor(dsum, 32);
    f32x4 aI[8], aC[8];
#pragma unroll
    for (int et = 0; et < 8; ++et) { aI[et] = (f32x4){0.f, 0.f, 0.f, 0.f}; aC[et] = (f32x4){0.f, 0.f, 0.f, 0.f}; }
#pragma unroll
    for (int i = 0; i < 4; ++i) {
        if (2 * i <= w) {
            const v4u pv = (v4u){pw[2 * i].x, pw[2 * i].y, pw[2 * i + 1].x, pw[2 * i + 1].y}; const bf16x8 pb = __builtin_bit_cast(bf16x8, pv);
#pragma unroll
            for (int et = 0; et < 8; ++et) { const bf16* vp = VT + (size_t)(h * 128 + 16 * et + fr) * T + t0 + 32 * i + 4 * g;
                const v2u lo = *(const GAS v2u*)vp, hi = *(const GAS v2u*)(vp + 16); const v4u vv = (v4u){lo.x, lo.y, hi.x, hi.y};
                aI[et] = MFMA16(__builtin_bit_cast(bf16x8, vv), pb, aI[et]); }
        }
    }
#pragma unroll
    for (int kk = 0; kk < 4; ++kk)
#pragma unroll
        for (int et = 0; et < 8; ++et) { const bf16x8 cf = *(const GAS bf16x8*)(CT + (size_t)(16 * et + fr) * 128 + 32 * kk + 8 * g); aC[et] = MFMA16(cf, qf[kk], aC[et]); }
    const float den = dsum + sci * qn, dn = fmaxf(fabsf(den), __expf(-mt)), rden = 1.0f / dn;
    const bf16* MO = (const bf16*)(F.ws + WS_MO) + (size_t)(t0 + tl) * 512 + h * 128; const float* gn = F.in[I_MNG] + h * 128;
    float ss = 0.f;
#pragma unroll
    for (int et = 0; et < 8; ++et) { const v2u mo = *(const GAS v2u*)(MO + 16 * et + 4 * g);
        const float o0 = sigm(bflo(mo.x)), o1 = sigm(bfhi(mo.x)), o2 = sigm(bflo(mo.y)), o3 = sigm(bfhi(mo.y));
        f32x4 hv = (aI[et] + aC[et] * sci) * rden; hv[0] *= o0; hv[1] *= o1; hv[2] *= o2; hv[3] *= o3; aI[et] = hv;
        ss += (hv[0] * hv[0] + hv[1] * hv[1]) + (hv[2] * hv[2] + hv[3] * hv[3]); }
    ss += __shfl_xor(ss, 16); ss += __shfl_xor(ss, 32);
    const float rs = 1.0f / sqrtf(ss * (1.0f / 128.0f) + 1e-6f);
    bf16* YM = (bf16*)(F.ws + WS_YM) + (size_t)(t0 + tl) * 512 + h * 128;
#pragma unroll
    for (int et = 0; et < 8; ++et) { const f32x4 gg = *(const f32x4*)(gn + 16 * et + 4 * g); v2u o; o.x = pk2(aI[et][0] * rs * gg.x, aI[et][1] * rs * gg.y); o.y = pk2(aI[et][2] * rs * gg.z, aI[et][3] * rs * gg.w);
        *(GAS v2u*)(YM + 16 * et + 4 * g) = o; }
}
__device__ __forceinline__ void p5_mlstm_out(Frame& F) {
#pragma unroll 1
    for (int k = 0; k < 2; ++k) { const int item = F.vcu * 2 + k; mlstm_out_item(F, item & 3, item >> 2); }
}

__device__ __forceinline__ void p8_route(Frame& F) {
    { LAS float* scr = (LAS float*)(F.lds + F.wave * 16384); const int gw = F.vcu * NWAVES + F.wave, NGW = F.G * NWAVES;
      for (int it = gw; it < 16384 + 8192; it += NGW) {
          if (it < 16384) { const int nb = it & 3, kb = (it >> 2) & 15, gu = (it >> 6) & 1, j = (it >> 7) & 3, e = it >> 9;
              transpose_item(F.in[gu ? I_EWU : I_EWG] + (size_t)e * 1024 * 512, 512, j * 128, (bf16*)(F.ws + WS_WEUP), 1024, (e * 4 + j) * 256 + gu * 128, scr, kb, nb, F.lane); }
          else { const int r = it - 16384, nb = r & 31, kb = (r >> 5) & 7, e = r >> 8;
              transpose_item(F.in[I_EWD] + (size_t)e * 512 * 1024, 1024, 0, (bf16*)(F.ws + WS_WEDN), 512, e * 1024, scr, kb, nb, F.lane); } } }
    __syncthreads();
    LAS float* tab = (LAS float*)F.lds;
    for (int idx = F.tid; idx < 36864; idx += NWAVES * 64) { const int k = idx / 36, c = idx - k * 36; tab[idx] = c < 4 ? F.in[I_RGW][k * 4 + c] : F.in[I_REW][k * 32 + (c - 4)]; }
    if (F.tid < 32) F.MISC[32 + F.tid] = 0u;
    __syncthreads();
    const float* gain = F.in[I_FFNG]; bf16* XN = (bf16*)(F.ws + WS_XN);
    f32x4 gv[4];
#pragma unroll
    for (int j = 0; j < 4; ++j) gv[j] = *(const f32x4*)(gain + 4 * F.lane + 256 * j);
#pragma unroll 1
    for (int i = 0; i < 8; ++i) {
        const int row = 64 * F.vcu + 8 * F.wave + i;
        const GAS f32x4* xr = (const GAS f32x4*)(F.out + (size_t)row * D) + F.lane;
        f32x4 v[4]; float ss = 0.f;
#pragma unroll
        for (int j = 0; j < 4; ++j) { v[j] = xr[64 * j]; ss += (v[j].x * v[j].x + v[j].y * v[j].y) + (v[j].z * v[j].z + v[j].w * v[j].w); }
        const float rs = 1.0f / sqrtf(wave_sum(ss) * (1.f / D) + 1e-6f);
        GAS unsigned long long* o8 = (GAS unsigned long long*)(XN + (size_t)row * D) + F.lane;
        float lg[36];
#pragma unroll
        for (int c = 0; c < 36; ++c) lg[c] = 0.f;
#pragma unroll
        for (int j = 0; j < 4; ++j) { v[j] = v[j] * rs * gv[j];
            o8[64 * j] = (unsigned long long)pk2(v[j].x, v[j].y) | ((unsigned long long)pk2(v[j].z, v[j].w) << 32);
#pragma unroll
            for (int e = 0; e < 4; ++e) { const LAS f32x4* wp = (const LAS f32x4*)(tab + (4 * F.lane + 256 * j + e) * 36); const float xv = v[j][e];
#pragma unroll
                for (int q = 0; q < 9; ++q) { const f32x4 w4 = wp[q]; lg[4 * q] += xv * w4.x; lg[4 * q + 1] += xv * w4.y; lg[4 * q + 2] += xv * w4.z; lg[4 * q + 3] += xv * w4.w; } } }
#pragma unroll
        for (int c = 0; c < 36; ++c) lg[c] = wave_sum(lg[c]);
        const float* rgb = F.in[I_RGB]; const float* reb = F.in[I_REB];
        float gl[4]; int grp = 0; float gmx;
#pragma unroll
        for (int c = 0; c < 4; ++c) gl[c] = lg[c] + rgb[c];
        gmx = gl[0];
#pragma unroll
        for (int c = 1; c < 4; ++c) if (gl[c] > gmx) { gmx = gl[c]; grp = c; }
        float gz = 0.f;
#pragma unroll
        for (int c = 0; c < 4; ++c) gz += __expf(gl[c] - gmx);
        const float pgrp = 1.0f / gz;
        float el[8];
#pragma unroll
        for (int c = 0; c < 8; ++c) { const float a = grp == 0 ? lg[4 + c] : grp == 1 ? lg[12 + c] : grp == 2 ? lg[20 + c] : lg[28 + c]; el[c] = a + reb[grp * 8 + c]; }
        int i1 = 0; float m1 = el[0];
#pragma unroll
        for (int c = 1; c < 8; ++c) if (el[c] > m1) { m1 = el[c]; i1 = c; }
        int i2 = -1; float m2 = -INFINITY;
#pragma unroll
        for (int c = 0; c < 8; ++c) if (c != i1 && el[c] > m2) { m2 = el[c]; i2 = c; }
        const float e2 = __expf(m2 - m1), w1 = pgrp / (1.0f + e2), w2 = pgrp * e2 / (1.0f + e2);
        if (F.lane == 0) { int* RE = (int*)(F.ws + WS_RE); float* RW = (float*)(F.ws + WS_RW);
            RE[row * 2] = grp * 8 + i1; RE[row * 2 + 1] = grp * 8 + i2; RW[row * 2] = w1; RW[row * 2 + 1] = w2;
            __hip_atomic_fetch_add((LAS unsigned*)(F.MISC + 32 + grp * 8 + i1), 1u, __ATOMIC_RELAXED, __HIP_MEMORY_SCOPE_WORKGROUP);
            __hip_atomic_fetch_add((LAS unsigned*)(F.MISC + 32 + grp * 8 + i2), 1u, __ATOMIC_RELAXED, __HIP_MEMORY_SCOPE_WORKGROUP); }
    }
    __syncthreads();
    if (F.tid < 32) ((int*)(F.ws + WS_CNT))[F.vcu * 32 + F.tid] = (int)F.MISC[32 + F.tid];
    __syncthreads();
}

__device__ __forceinline__ void p9_permute(Frame& F) {
    LAS int* pt = (LAS int*)F.lds; LAS int* pp = pt + 512; LAS int* tot = pt + 1024; LAS int* pre = pt + 1056; LAS int* poff = pt + 1088; LAS int* es = pt + 1152; LAS int* sl = pt + 1280;
    const int* CNT = (const int*)(F.ws + WS_CNT);
    { const int e = F.tid & 31, part = F.tid >> 5; int s = 0, p = 0;
      for (int wg = part * 16; wg < part * 16 + 16; ++wg) { const int c = CNT[wg * 32 + e]; s += c; if (wg < F.vcu) p += c; }
      pt[part * 32 + e] = s; pp[part * 32 + e] = p; }
    __syncthreads();
    if (F.tid < 32) { int s = 0, p = 0; for (int q = 0; q < 16; ++q) { s += pt[q * 32 + F.tid]; p += pp[q * 32 + F.tid]; } tot[F.tid] = s; pre[F.tid] = p; }
    __syncthreads();
    if (F.tid == 0) { int off = 0; for (int e = 0; e < 32; ++e) { poff[e] = off; off += ((tot[e] + 255) >> 8) << 8; } poff[32] = off; }
    const int* RE = (const int*)(F.ws + WS_RE); const float* RW = (const float*)(F.ws + WS_RW);
    if (F.tid < 128) es[F.tid] = RE[(64 * F.vcu) * 2 + F.tid];
    __syncthreads();
    if (F.tid < 128) { const int e = es[F.tid]; int rank = 0; for (int q = 0; q < F.tid; ++q) rank += (es[q] == e) ? 1 : 0;
        const int slot = poff[e] + pre[e] + rank; sl[F.tid] = slot;
        ((int*)(F.ws + WS_TSLOT))[(64 * F.vcu) * 2 + F.tid] = slot; ((float*)(F.ws + WS_ROWW))[slot] = RW[(64 * F.vcu) * 2 + F.tid]; }
    __syncthreads();
    const bf16* XN = (const bf16*)(F.ws + WS_XN); bf16* XS = (bf16*)(F.ws + WS_XS);
#pragma unroll 4
    for (int q = 0; q < 16; ++q) { const int i = 16 * F.wave + q, t = 64 * F.vcu + (i >> 1), slot = sl[i];
        const GAS v4u* s = (const GAS v4u*)(XN + (size_t)t * 1024); GAS v4u* d = (GAS v4u*)(XS + (size_t)slot * 1024);
        d[F.lane] = s[F.lane]; d[F.lane + 64] = s[F.lane + 64]; }
    if (F.vcu < 32) { const int e = F.vcu; for (int s = poff[e] + tot[e] + F.tid; s < poff[e + 1]; s += NWAVES * 64) ((float*)(F.ws + WS_ROWW))[s] = 0.f; }
    if (F.vcu == 0) { int* BLKE = (int*)(F.ws + WS_BLKE);
        if (F.tid < 160) { int e = 0; for (int q = 0; q < 32; ++q) if (256 * F.tid >= poff[q + 1]) e = q + 1; BLKE[F.tid] = e < 32 ? e : 0; }
        if (F.tid == 0) BLKE[192] = poff[32] >> 8; }
    __syncthreads();
}

__device__ __forceinline__ void p12_combine(Frame& F) {
    const float* gain = F.in[I_PLEG]; bf16* XN = (bf16*)(F.ws + WS_XN); const bf16* YB = (const bf16*)(F.ws + WS_YB); const int* TS = (const int*)(F.ws + WS_TSLOT);
    f32x4 gv[4];
#pragma unroll
    for (int j = 0; j < 4; ++j) gv[j] = *(const f32x4*)(gain + 4 * F.lane + 256 * j);
#pragma unroll 1
    for (int i = 0; i < 8; ++i) {
        const int row = 64 * F.vcu + 8 * F.wave + i; const int s0 = TS[row * 2], s1 = TS[row * 2 + 1];
        GAS f32x4* xr = (GAS f32x4*)(F.out + (size_t)row * D) + F.lane;
        const GAS v2u* y0 = (const GAS v2u*)(YB + (size_t)s0 * 1024) + F.lane; const GAS v2u* y1 = (const GAS v2u*)(YB + (size_t)s1 * 1024) + F.lane;
        f32x4 v[4]; float ss = 0.f;
#pragma unroll
        for (int j = 0; j < 4; ++j) { v[j] = xr[64 * j]; const v2u a = y0[64 * j], b = y1[64 * j];
            v[j].x += bflo(a.x) + bflo(b.x); v[j].y += bfhi(a.x) + bfhi(b.x); v[j].z += bflo(a.y) + bflo(b.y); v[j].w += bfhi(a.y) + bfhi(b.y);
            xr[64 * j] = v[j]; ss += (v[j].x * v[j].x + v[j].y * v[j].y) + (v[j].z * v[j].z + v[j].w * v[j].w); }
        const float rs = 1.0f / sqrtf(wave_sum(ss) * (1.f / D) + 1e-6f);
        GAS unsigned long long* o8 = (GAS unsigned long long*)(XN + (size_t)row * D) + F.lane;
#pragma unroll
        for (int j = 0; j < 4; ++j) { const f32x4 q = v[j] * rs * gv[j]; o8[64 * j] = (unsigned long long)pk2(q.x, q.y) | ((unsigned long long)pk2(q.z, q.w) << 32); }
    }
}
__device__ __forceinline__ void p14_final(Frame& F) {
    const float* gain = F.in[I_FING];
    f32x4 gv[4];
#pragma unroll
    for (int j = 0; j < 4; ++j) gv[j] = *(const f32x4*)(gain + 4 * F.lane + 256 * j);
#pragma unroll 1
    for (int i = 0; i < 8; ++i) {
        const int row = 64 * F.vcu + 8 * F.wave + i;
        GAS f32x4* xr = (GAS f32x4*)(F.out + (size_t)row * D) + F.lane;
        f32x4 v[4]; float ss = 0.f;
#pragma unroll
        for (int j = 0; j < 4; ++j) { v[j] = xr[64 * j]; ss += (v[j].x * v[j].x + v[j].y * v[j].y) + (v[j].z * v[j].z + v[j].w * v[j].w); }
        const float rs = 1.0f / sqrtf(wave_sum(ss) * (1.f / D) + 1e-6f);
#pragma unroll
        for (int j = 0; j < 4; ++j) xr[64 * j] = v[j] * rs * gv[j];
    }
}

struct Args { const float* in[24]; float* out; unsigned char* ws; int ph_lo, ph_hi; };
__global__ void __launch_bounds__(NWAVES * 64, 2) mk_fwd(Args args) {
    extern __shared__ __attribute__((aligned(16))) unsigned char lds[];
    Frame F;
    F.lds = (LAS unsigned char*)lds;
    F.MISC = (volatile LAS unsigned*)(F.lds + MISC_OFF);
    F.wave = __builtin_amdgcn_readfirstlane((int)threadIdx.x >> 6); F.lane = (int)__builtin_amdgcn_mbcnt_hi(~0u, __builtin_amdgcn_mbcnt_lo(~0u, 0u)); F.tid = F.wave * 64 + F.lane;
    F.G = gridDim.x; { const int bx = blockIdx.x; F.vcu = (F.G % 8 == 0) ? (bx % 8) * (F.G / 8) + bx / 8 : bx; }
    F.ws = args.ws; F.ctl = (gu32*)(args.ws + WS_CTL); F.out = args.out;
    F.in = args.in;
    for (int u = F.tid; u < (LDS_BYTES - MISC_OFF) / 4; u += NWAVES * 64) ((LAS unsigned*)(F.lds + MISC_OFF))[u] = 0u;
    __syncthreads();
#if MK_PER_PHASE
#define GRID_BAR() do { } while (0)
#else
    const XcdBarrier bar = xcd_barrier_post((unsigned*)(F.ctl + CW_BAR), F.MISC + 8);
#define GRID_BAR() xcd_barrier(bar)
#endif
    const int lo = args.ph_lo, hi = args.ph_hi;
#ifndef MK_MASK
#define MK_MASK 0x7fff
#endif
#define IN(k) (((MK_MASK >> (k)) & 1) && lo <= (k) && (k) < hi)
#define SEAM(k) do { if (IN(k) && IN((k) + 1)) GRID_BAR(); } while (0)
    bf16* const XN = (bf16*)(F.ws + WS_XN);

#define FRESH() do { int l_; asm volatile("v_mbcnt_lo_u32_b32 %0, -1, 0\n\tv_mbcnt_hi_u32_b32 %0, -1, %0" : "=v"(l_)); F.lane = l_; F.tid = F.wave * 64 + l_; } while (0)
    if (IN(0)) { FRESH(); p0_prologue(F); } SEAM(0);
    if (IN(1)) {
        FRESH(); p1_kmean(F);
        pg8::Gemm g{XN, (const bf16*)(F.ws + WS_WIN), T, N1, 1024}; pg8::StaticOrder S; S.init(T, N1, F.G, (int)blockIdx.x);
        pg8::EpiG1 E{(bf16*)(F.ws + WS_O7), (bf16*)(F.ws + WS_GA), F.in[I_BGATE]};
        pg8::gemm_phase<pg8::EpiG1, pg8::StaticOrder, true, true>(F.lds, g, S, E, F.wave);
    } SEAM(1);
    if (IN(2)) { FRESH(); p2_layout_select(F);
#if defined(MK_DEBUG)
        dbg_fill_sentinel(F); if (blockIdx.x == 0 && F.tid < 2) __hip_atomic_store(F.ctl + CW_QUEUE + 64 * (4 + F.tid), 0u, RLX_AGENT);
#endif
    } SEAM(2);
    if (IN(3)) { FRESH(); p3_attention(F); } SEAM(3);
#if defined(MK_DEBUG)
    if (IN(4)) { FRESH(); dbg_check(F); }
    if (IN(5)) { FRESH(); dbg_report(F); }
    if (lo >= 4) return;
#endif
    if (IN(4)) { FRESH(); p4_scan_combine(F); } SEAM(4);
    if (IN(5)) { FRESH(); p5_mlstm_out(F); } SEAM(5);
    if (IN(6)) {
        { pg8::Gemm g{(const bf16*)(F.ws + WS_YA), (const bf16*)(F.ws + WS_WUA), T, 1024, 512}; pg8::StaticOrder S; S.init(T, 1024, F.G, (int)blockIdx.x);
          pg8::EpiGateMul E{(const bf16*)(F.ws + WS_GA), nullptr, (bf16*)(F.ws + WS_T1)};
          pg8::gemm_phase<pg8::EpiGateMul, pg8::StaticOrder, true, true>(F.lds, g, S, E, F.wave); }
        { pg8::Gemm g{(const bf16*)(F.ws + WS_YM), (const bf16*)(F.ws + WS_WUM), T, 1024, 512}; pg8::StaticOrder S; S.init(T, 1024, F.G, (int)blockIdx.x);
          pg8::EpiGateMul E{(const bf16*)(F.ws + WS_GM), (const bf16*)(F.ws + WS_T1), (bf16*)(F.ws + WS_MERGED)};
          pg8::gemm_phase<pg8::EpiGateMul, pg8::StaticOrder, true, true>(F.lds, g, S, E, F.wave); }
    } SEAM(6);
    if (IN(7)) {
        pg8::Gemm g{(const bf16*)(F.ws + WS_MERGED), (const bf16*)(F.ws + WS_WOUT), T, 1024, 1024}; pg8::StaticOrder S; S.init(T, 1024, F.G, (int)blockIdx.x);
        pg8::EpiResF32 E{F.in[I_X], F.out};
        pg8::gemm_phase<pg8::EpiResF32, pg8::StaticOrder, true, true>(F.lds, g, S, E, F.wave);
    } SEAM(7);
    if (IN(8)) { FRESH(); p8_route(F); } SEAM(8);
    if (IN(9)) { FRESH(); p9_permute(F); } SEAM(9);
    if (IN(10)) {
        const int* BLKE = (const int*)(F.ws + WS_BLKE); const int nblk = BLKE[192];
        pg8::Gemm g{(const bf16*)(F.ws + WS_XS), (const bf16*)(F.ws + WS_WEUP), 40960, 32768, 1024}; pg8::MoeOrder S{BLKE, nblk * 4, F.G, F.vcu};
        pg8::EpiMoeUp E{(bf16*)(F.ws + WS_HID)};
        pg8::gemm_phase<pg8::EpiMoeUp, pg8::MoeOrder, true, true>(F.lds, g, S, E, F.wave);
    } SEAM(10);
    if (IN(11)) {
        const int* BLKE = (const int*)(F.ws + WS_BLKE); const int nblk = BLKE[192];
        pg8::Gemm g{(const bf16*)(F.ws + WS_HID), (const bf16*)(F.ws + WS_WEDN), 40960, 32768, 512}; pg8::MoeOrder S{BLKE, nblk * 4, F.G, F.vcu};
        pg8::EpiMoeDown E{(bf16*)(F.ws + WS_YB), (const float*)(F.ws + WS_ROWW)};
        pg8::gemm_phase<pg8::EpiMoeDown, pg8::MoeOrder, true, true>(F.lds, g, S, E, F.wave);
    } SEAM(11);
    if (IN(12)) { FRESH(); p12_combine(F); } SEAM(12);
    if (IN(13)) {
        { pg8::Gemm g{(const bf16*)(F.ws + WS_PB), (const bf16*)(F.ws + WS_WPP), T, 1024, 256}; pg8::StaticOrder S; S.init(T, 1024, F.G, (int)blockIdx.x);
          pg8::EpiPlain E{(bf16*)(F.ws + WS_PJ)};
          pg8::gemm_phase<pg8::EpiPlain, pg8::StaticOrder, true, true>(F.lds, g, S, E, F.wave); }
        { pg8::Gemm g{XN, (const bf16*)(F.ws + WS_WPG), T, 1024, 1024}; pg8::StaticOrder S; S.init(T, 1024, F.G, (int)blockIdx.x);
          pg8::EpiPleGate E{(const bf16*)(F.ws + WS_PJ), F.out};
          pg8::gemm_phase<pg8::EpiPleGate, pg8::StaticOrder, true, true>(F.lds, g, S, E, F.wave); }
    } SEAM(13);
    if (IN(14)) { FRESH(); p14_final(F); }
#if defined(MK_DUMP)
    if (lo == MK_DUMP) { FRESH(); dbg_dump_bf16(F, MK_DUMP_OFF, MK_DUMP_LD, MK_DUMP_NC); }
#endif
#undef IN
#undef SEAM
}

extern "C" void kernel_launch(void* const* d_in, const int* in_sizes, int n_in, void* d_out, int out_size, void* d_ws, size_t ws_size, hipStream_t stream) {
    static int grid = 0;
    if (grid == 0) {
        if (n_in != 24 || in_sizes[0] != T * D || out_size != T * D || ws_size < WS_END) { fprintf(stderr, "kernel_launch: shape/workspace mismatch (n_in %d, in0 %d, out %d, ws %zu < %zu)\n", n_in, n_in > 0 ? in_sizes[0] : -1, out_size, ws_size, (size_t)WS_END); grid = -1; return; }
        int dev = 0, cus = 0, per_cu = 0;
        if (hipGetDevice(&dev) != hipSuccess || hipDeviceGetAttribute(&cus, hipDeviceAttributeMultiprocessorCount, dev) != hipSuccess) { grid = -1; return; }
        if (hipFuncSetAttribute((const void*)mk_fwd, hipFuncAttributeMaxDynamicSharedMemorySize, LDS_BYTES) != hipSuccess) { fprintf(stderr, "kernel_launch: hipFuncSetAttribute failed\n"); grid = -1; return; }
        if (hipOccupancyMaxActiveBlocksPerMultiprocessor(&per_cu, (const void*)mk_fwd, NWAVES * 64, LDS_BYTES) != hipSuccess || per_cu < 1) { fprintf(stderr, "kernel_launch: occupancy query says %d blocks per CU\n", per_cu); (void)hipGetLastError(); grid = -1; return; }
        if (cus != 256) { fprintf(stderr, "kernel_launch: built for 256 CUs, device has %d\n", cus); grid = -1; return; }
        grid = cus;
    }
    if (grid < 0) return;
    (void)hipMemsetAsync((char*)d_ws + WS_CTL, 0, CTL_ZERO_BYTES, stream);
    Args a{};
    for (int i = 0; i < 24; ++i) a.in[i] = (const float*)d_in[i];
    a.out = (float*)d_out; a.ws = (unsigned char*)d_ws;
#if MK_PER_PHASE
    for (int ph = 0; ph < NPH; ++ph) { a.ph_lo = ph; a.ph_hi = ph + 1; hipLaunchKernelGGL(mk_fwd, dim3(grid), dim3(NWAVES * 64), LDS_BYTES, stream, a); }
#else
    a.ph_lo = 0; a.ph_hi = NPH; hipLaunchKernelGGL(mk_fwd, dim3(grid), dim3(NWAVES * 64), LDS_BYTES, stream, a);
#endif
}
```

```cpp
#include <hip/hip_runtime.h>
#include <cstdio>
#include <cstdint>
#define MK_PER_PHASE 0
#define MK_MASK 0x7fff
#define MK_P3 7
#define MK_DUP -1
namespace pg8 {
#define PG8_LAS __attribute__((address_space(3)))
typedef unsigned short bf16_t;
typedef short bf16x8 __attribute__((ext_vector_type(8)));
typedef float f32x4 __attribute__((ext_vector_type(4)));
typedef unsigned u32x4 __attribute__((ext_vector_type(4)));
constexpr int BM = 256, BK = 64, HALF = 128, HTB = HALF * BK * 2  , STAGE_BYTES = 8 * HTB, NXCD = 8, WGM = 8;

__host__ __device__ __forceinline__ int lds_byte(int r, int c) { const int st = (r >> 4) * 2 + (c >> 5), rr = r & 15, cc = c & 31, ob = rr * 64 + cc * 2; return st * 1024 + (ob ^ (((ob >> 9) & 1) << 5)); }
__host__ __device__ __forceinline__ void stage_rc(int b, int& R, int& C) { const int st = b / 1024, sb = b % 1024, swz = sb ^ (((sb >> 9) & 1) << 5); R = (st >> 1) * 16 + swz / 64; C = (st & 1) * 32 + (swz % 64) / 2; }
__host__ __device__ __forceinline__ int perm32(int rho) { const int n = rho >> 4, i = rho & 15; return 8 * (i >> 2) + 4 * n + (i & 3); }

struct Unit { int pm, pn; };
struct Gemm { const bf16_t* A; const bf16_t* Bt; int M, N, K; };

struct StaticOrder {
    int nM, nN, nwg, G, c;
    __host__ __device__ void init(int M, int N, int G_, int c_) { nM = M / BM; nN = N / BM; nwg = nM * nN; G = G_; c = c_; }
    __host__ __device__ bool next(int i, Unit& u) const {
        const long L = (long)i * G + c; if (L >= nwg) return false;
        int wgid = (int)L; { const int q = nwg / NXCD, r = nwg % NXCD, xcd = wgid % NXCD, off = wgid / NXCD; wgid = (xcd < r ? xcd * (q + 1) : r * (q + 1) + (xcd - r) * q) + off; }
        const int nig = WGM * nN, gid = wgid / nig, fm = gid * WGM, gsz = (nM - fm) < WGM ? (nM - fm) : WGM;
        u.pm = fm + ((wgid % nig) % gsz); u.pn = (wgid % nig) / gsz; return true;
    }
    __device__ __forceinline__ void a_ready(const Unit&) const {}
    __device__ __forceinline__ void done(const Unit&) const {}
};

typedef float f32x2c __attribute__((ext_vector_type(2)));
typedef __bf16 bf16x2c __attribute__((ext_vector_type(2)));
__device__ __forceinline__ unsigned cvt_pk_bf16(float lo, float hi) { const f32x2c v = {lo, hi}; const bf16x2c b = __builtin_convertvector(v, bf16x2c); return __builtin_bit_cast(unsigned, b); }
typedef float f32x2 __attribute__((ext_vector_type(2)));
__device__ __forceinline__ f32x2 gelu_pk(f32x2 v) {
    const f32x2 av = __builtin_elementwise_abs(v), d = av * 0.2316418882f + 1.0f;
    f32x2 t; t.x = __builtin_amdgcn_rcpf(d.x); t.y = __builtin_amdgcn_rcpf(d.y);
    f32x2 q = t * 0.5307027145f + (-0.7265760135f); q = q * t + 0.7107068705f; q = q * t + (-0.142248368f); q = q * t + 0.127414796f; q = q * t;
    const f32x2 s = (v * v) * (-0.72134752044f);
    f32x2 e; e.x = __builtin_amdgcn_exp2f(s.x); e.y = __builtin_amdgcn_exp2f(s.y);
    const f32x2 m = v * (q * e), r = v - m;
    f32x2 o; o.x = v.x < 0.f ? m.x : r.x; o.y = v.y < 0.f ? m.y : r.y; return o;
}

template <int ACT  > struct EpiBf16 {
    static constexpr bool PERM = true, AFTER_DRAIN = false; static_assert(ACT == 0 || ACT == 1, "EpiBf16: ACT is 0 (none) or 1 (gelu_pk)");
    bf16_t* O; int ldc; const float* bias; int split_cols; size_t split_stride; float scale0;
    __device__ __forceinline__ void operator()(const f32x4 (&acc)[2][2][4][2], const Unit& u, int wr, int wc, int fr, int fq) const {
        const int row0 = u.pm * BM + wr * 64 + fr; int colt = u.pn * BM; bf16_t* base = O;
        float sc = 1.f; if (split_cols) { const int t = colt / split_cols; base += (size_t)t * split_stride; colt -= t * split_cols; if (t == 0) sc = scale0; }
        const int col0 = colt + wc * 32 + 8 * fq, bcol0 = u.pn * BM + wc * 32 + 8 * fq;
        f32x4 bv[2][2];
#pragma unroll
        for (int bj = 0; bj < 2; ++bj)
#pragma unroll
            for (int n = 0; n < 2; ++n) bv[bj][n] = bias ? *(const f32x4*)(bias + bcol0 + bj * HALF + 4 * n) : (f32x4){0.f, 0.f, 0.f, 0.f};
#pragma unroll
        for (int ai = 0; ai < 2; ++ai)
#pragma unroll
            for (int m = 0; m < 4; ++m) { bf16_t* rowp = base + (size_t)(row0 + ai * HALF + m * 16) * ldc + col0;
#pragma unroll
                for (int bj = 0; bj < 2; ++bj) { f32x4 v0 = acc[ai][bj][m][0] + bv[bj][0], v1 = acc[ai][bj][m][1] + bv[bj][1];
                    if (ACT == 1) { f32x2 a = gelu_pk((f32x2){v0[0], v0[1]}), b = gelu_pk((f32x2){v0[2], v0[3]}), c = gelu_pk((f32x2){v1[0], v1[1]}), d = gelu_pk((f32x2){v1[2], v1[3]});
                        v0 = (f32x4){a.x, a.y, b.x, b.y}; v1 = (f32x4){c.x, c.y, d.x, d.y}; }
                    v0 = v0 * sc; v1 = v1 * sc; u32x4 w; w.x = cvt_pk_bf16(v0[0], v0[1]); w.y = cvt_pk_bf16(v0[2], v0[3]); w.z = cvt_pk_bf16(v1[0], v1[1]); w.w = cvt_pk_bf16(v1[2], v1[3]);
                    *(u32x4*)(rowp + bj * HALF) = w; } }
    }
};

constexpr int TT = 16384;
typedef unsigned u32x2 __attribute__((ext_vector_type(2)));
__device__ __forceinline__ float sigm(float x) { return __builtin_amdgcn_rcpf(1.0f + __expf(-x)); }
__device__ __forceinline__ float bf_lo(unsigned w) { return __uint_as_float(w << 16); }
__device__ __forceinline__ float bf_hi(unsigned w) { return __uint_as_float(w & 0xffff0000u); }
__device__ __forceinline__ u32x4 pack8(const f32x4& a, const f32x4& b) { u32x4 w; w.x = cvt_pk_bf16(a[0], a[1]); w.y = cvt_pk_bf16(a[2], a[3]); w.z = cvt_pk_bf16(b[0], b[1]); w.w = cvt_pk_bf16(b[2], b[3]); return w; }

struct EpiG1 {
    static constexpr bool PERM = true, AFTER_DRAIN = false;
    bf16_t* O7; bf16_t* GA; const float* bgate;
    __device__ __forceinline__ void operator()(const f32x4 (&acc)[2][2][4][2], const Unit& u, int wr, int wc, int fr, int fq) const {
        const int row0 = u.pm * BM + wr * 64 + fr; const int pn = u.pn;
        if (pn < 14) {
            bf16_t* base = O7 + (size_t)(pn >> 1) * ((size_t)TT * 512); const int col0 = (pn & 1) * 256 + wc * 32 + 8 * fq; const float sc = pn < 2 ? 0.125f : 1.0f;
#pragma unroll
            for (int ai = 0; ai < 2; ++ai)
#pragma unroll
                for (int m = 0; m < 4; ++m) { bf16_t* rowp = base + (size_t)(row0 + ai * HALF + m * 16) * 512 + col0;
#pragma unroll
                    for (int bj = 0; bj < 2; ++bj) *(u32x4*)(rowp + bj * HALF) = pack8(acc[ai][bj][m][0] * sc, acc[ai][bj][m][1] * sc); }
        } else {
            const int gi = (pn - 14) >> 2, col0 = ((pn - 14) & 3) * 256 + wc * 32 + 8 * fq; bf16_t* base = GA + (size_t)gi * ((size_t)TT * 1024); const float* bp = bgate + gi * 1024 + col0;
            f32x4 bv[2][2];
#pragma unroll
            for (int bj = 0; bj < 2; ++bj)
#pragma unroll
                for (int n = 0; n < 2; ++n) bv[bj][n] = *(const f32x4*)(bp + bj * HALF + 4 * n);
#pragma unroll
            for (int ai = 0; ai < 2; ++ai)
#pragma unroll
                for (int m = 0; m < 4; ++m) { bf16_t* rowp = base + (size_t)(row0 + ai * HALF + m * 16) * 1024 + col0;
#pragma unroll
                    for (int bj = 0; bj < 2; ++bj) { f32x4 v0 = acc[ai][bj][m][0] + bv[bj][0], v1 = acc[ai][bj][m][1] + bv[bj][1];
#pragma unroll
                        for (int e = 0; e < 4; ++e) { v0[e] = sigm(v0[e]); v1[e] = sigm(v1[e]); }
                        *(u32x4*)(rowp + bj * HALF) = pack8(v0, v1); } }
        }
    }
};
struct EpiGateMul {
    static constexpr bool PERM = true, AFTER_DRAIN = false;
    const bf16_t* Gt; const bf16_t* Add; bf16_t* Out;
    __device__ __forceinline__ void operator()(const f32x4 (&acc)[2][2][4][2], const Unit& u, int wr, int wc, int fr, int fq) const {
        const int row0 = u.pm * BM + wr * 64 + fr, col0 = u.pn * BM + wc * 32 + 8 * fq;
#pragma unroll
        for (int ai = 0; ai < 2; ++ai)
#pragma unroll
            for (int m = 0; m < 4; ++m) { const size_t off = (size_t)(row0 + ai * HALF + m * 16) * 1024 + col0;
#pragma unroll
                for (int bj = 0; bj < 2; ++bj) { const u32x4 g = *(const u32x4*)(Gt + off + bj * HALF);
                    f32x4 v0 = acc[ai][bj][m][0], v1 = acc[ai][bj][m][1];
                    v0[0] *= bf_lo(g.x); v0[1] *= bf_hi(g.x); v0[2] *= bf_lo(g.y); v0[3] *= bf_hi(g.y); v1[0] *= bf_lo(g.z); v1[1] *= bf_hi(g.z); v1[2] *= bf_lo(g.w); v1[3] *= bf_hi(g.w);
                    if (Add) { const u32x4 a = *(const u32x4*)(Add + off + bj * HALF);
                        v0[0] += bf_lo(a.x); v0[1] += bf_hi(a.x); v0[2] += bf_lo(a.y); v0[3] += bf_hi(a.y); v1[0] += bf_lo(a.z); v1[1] += bf_hi(a.z); v1[2] += bf_lo(a.w); v1[3] += bf_hi(a.w); }
                    *(u32x4*)(Out + off + bj * HALF) = pack8(v0, v1); } }
    }
};
struct EpiResF32 {
    static constexpr bool PERM = false, AFTER_DRAIN = false;
    const float* base; float* out;
    __device__ __forceinline__ void operator()(const f32x4 (&acc)[2][2][4][2], const Unit& u, int wr, int wc, int fr, int fq) const {
        const int row0 = u.pm * BM + wr * 64 + fr, col0 = u.pn * BM + wc * 32 + 4 * fq;
#pragma unroll
        for (int ai = 0; ai < 2; ++ai)
#pragma unroll
            for (int m = 0; m < 4; ++m) { const size_t off = (size_t)(row0 + ai * HALF + m * 16) * 1024 + col0;
#pragma unroll
                for (int bj = 0; bj < 2; ++bj)
#pragma unroll
                    for (int n = 0; n < 2; ++n) *(f32x4*)(out + off + bj * HALF + n * 16) = *(const f32x4*)(base + off + bj * HALF + n * 16) + acc[ai][bj][m][n]; }
    }
};
struct EpiMoeUp {
    static constexpr bool PERM = true, AFTER_DRAIN = false;
    bf16_t* HID;
    __device__ __forceinline__ void operator()(const f32x4 (&acc)[2][2][4][2], const Unit& u, int wr, int wc, int fr, int fq) const {
        const int row0 = u.pm * BM + wr * 64 + fr, col0 = (u.pn & 3) * 128 + wc * 32 + 8 * fq;
#pragma unroll
        for (int ai = 0; ai < 2; ++ai)
#pragma unroll
            for (int m = 0; m < 4; ++m) { f32x4 h0, h1;
#pragma unroll
                for (int e = 0; e < 4; ++e) { const float g0 = acc[ai][0][m][0][e], g1 = acc[ai][0][m][1][e]; h0[e] = g0 * sigm(g0) * acc[ai][1][m][0][e]; h1[e] = g1 * sigm(g1) * acc[ai][1][m][1][e]; }
                *(u32x4*)(HID + (size_t)(row0 + ai * HALF + m * 16) * 512 + col0) = pack8(h0, h1); }
    }
};
struct EpiMoeDown {
    static constexpr bool PERM = true, AFTER_DRAIN = false;
    bf16_t* YB; const float* roww;
    __device__ __forceinline__ void operator()(const f32x4 (&acc)[2][2][4][2], const Unit& u, int wr, int wc, int fr, int fq) const {
        const int row0 = u.pm * BM + wr * 64 + fr, col0 = (u.pn & 3) * 256 + wc * 32 + 8 * fq;
#pragma unroll
        for (int ai = 0; ai < 2; ++ai)
#pragma unroll
            for (int m = 0; m < 4; ++m) { const int r = row0 + ai * HALF + m * 16; const float w = roww[r]; bf16_t* rowp = YB + (size_t)r * 1024 + col0;
#pragma unroll
                for (int bj = 0; bj < 2; ++bj) *(u32x4*)(rowp + bj * HALF) = pack8(acc[ai][bj][m][0] * w, acc[ai][bj][m][1] * w); }
    }
};
struct EpiPlain {
    static constexpr bool PERM = true, AFTER_DRAIN = false;
    bf16_t* Out;
    __device__ __forceinline__ void operator()(const f32x4 (&acc)[2][2][4][2], const Unit& u, int wr, int wc, int fr, int fq) const {
        const int row0 = u.pm * BM + wr * 64 + fr, col0 = u.pn * BM + wc * 32 + 8 * fq;
#pragma unroll
        for (int ai = 0; ai < 2; ++ai)
#pragma unroll
            for (int m = 0; m < 4; ++m) { bf16_t* rowp = Out + (size_t)(row0 + ai * HALF + m * 16) * 1024 + col0;
#pragma unroll
                for (int bj = 0; bj < 2; ++bj) *(u32x4*)(rowp + bj * HALF) = pack8(acc[ai][bj][m][0], acc[ai][bj][m][1]); }
    }
};
struct EpiPleGate {
    static constexpr bool PERM = true, AFTER_DRAIN = false;
    const bf16_t* PJ; float* out;
    __device__ __forceinline__ void operator()(const f32x4 (&acc)[2][2][4][2], const Unit& u, int wr, int wc, int fr, int fq) const {
        const int row0 = u.pm * BM + wr * 64 + fr, col0 = u.pn * BM + wc * 32 + 8 * fq;
#pragma unroll
        for (int ai = 0; ai < 2; ++ai)
#pragma unroll
            for (int m = 0; m < 4; ++m) { const size_t off = (size_t)(row0 + ai * HALF + m * 16) * 1024 + col0;
#pragma unroll
                for (int bj = 0; bj < 2; ++bj) { const u32x4 p = *(const u32x4*)(PJ + off + bj * HALF);
                    f32x4 o0 = *(const f32x4*)(out + off + bj * HALF), o1 = *(const f32x4*)(out + off + bj * HALF + 4);
                    const f32x4 a0 = acc[ai][bj][m][0], a1 = acc[ai][bj][m][1];
                    o0[0] += bf_lo(p.x) * sigm(a0[0]); o0[1] += bf_hi(p.x) * sigm(a0[1]); o0[2] += bf_lo(p.y) * sigm(a0[2]); o0[3] += bf_hi(p.y) * sigm(a0[3]);
                    o1[0] += bf_lo(p.z) * sigm(a1[0]); o1[1] += bf_hi(p.z) * sigm(a1[1]); o1[2] += bf_lo(p.w) * sigm(a1[2]); o1[3] += bf_hi(p.w) * sigm(a1[3]);
                    *(f32x4*)(out + off + bj * HALF) = o0; *(f32x4*)(out + off + bj * HALF + 4) = o1; }
                asm volatile("" ::: "memory"); }
    }
};
struct MoeOrder {
    const int* blke; int nunits, G, c;
    __device__ __forceinline__ bool next(int i, Unit& u) const { const int U = i * G + c; if (U >= nunits) return false; const int b = U >> 2; u.pm = b; u.pn = blke[b] * 4 + (U & 3); return true; }
    __device__ __forceinline__ void a_ready(const Unit&) const {}
    __device__ __forceinline__ void done(const Unit&) const {}
};
template <class Epi, class Sched, bool ALIGN_EPI = false, bool SP2 = false>
__device__ __forceinline__ void gemm_phase(PG8_LAS unsigned char* lds, const Gemm g, const Sched& S, const Epi& E, const int wave_id  ) {
    int lane_; asm volatile("v_mbcnt_lo_u32_b32 %0, -1, 0\n\tv_mbcnt_hi_u32_b32 %0, -1, %0" : "=v"(lane_));
    const int tid_ = wave_id * 64 + lane_;
    const int tid = tid_, wid = __builtin_amdgcn_readfirstlane(tid >> 6), lane = tid & 63, wr = wid >> 2, wc = wid & 3, fr = lane & 15, fq = lane >> 4;
    int K_ = g.K; asm volatile("" : "+s"(K_));
    const int K = K_, nt = K / BK;
    unsigned voffA[2], voffB[2];
#pragma unroll
    for (int i = 0; i < 2; ++i) { int R, C; stage_rc(tid * 16 + i * 8192, R, C); const int Rb = Epi::PERM ? ((R & ~31) + perm32(R & 31)) : R;
        voffA[i] = (unsigned)(R * K + C) * 2u; voffB[i] = (unsigned)(Rb * K + C) * 2u; }
    const size_t kstep = (size_t)(BK * 2);
    const size_t hstep = (size_t)HALF * K * 2;
    const size_t tstep = 2 * hstep;
    const unsigned ldsw = (unsigned)wid * 1024u;
    const int aoff = lds_byte(wr * 64 + fr, fq * 8), boff = lds_byte(wc * 32 + fr, fq * 8);
#define PG8_SA(b, h) (((b) * 2 + (h)) * HTB)
#define PG8_SB(b, h) ((4 + (b) * 2 + (h)) * HTB)
#define PG8_STAGE(bufoff, gbase, voff) do { _Pragma("unroll") for (int _i = 0; _i < 2; ++_i) \
        __builtin_amdgcn_global_load_lds((const unsigned*)((const char*)(gbase) + (voff)[_i]), (PG8_LAS unsigned*)(lds + (bufoff) + ldsw + _i * 8192), 16, 0, 0); } while (0)
#define PG8_LDA(dst, b, h) do { _Pragma("unroll") for (int m = 0; m < 4; ++m) _Pragma("unroll") for (int k = 0; k < 2; ++k) dst[m][k] = *(const PG8_LAS bf16x8*)(lds + PG8_SA(b, h) + aoff + m * 2048 + k * 1024); } while (0)
#define PG8_LDB(dst, b, h) do { _Pragma("unroll") for (int n = 0; n < 2; ++n) _Pragma("unroll") for (int k = 0; k < 2; ++k) dst[n][k] = *(const PG8_LAS bf16x8*)(lds + PG8_SB(b, h) + boff + n * 2048 + k * 1024); } while (0)
#define PG8_MMA(ai, bj, At, Bt) do { __builtin_amdgcn_s_setprio(1); _Pragma("unroll") for (int m = 0; m < 4; ++m) _Pragma("unroll") for (int n = 0; n < 2; ++n) _Pragma("unroll") for (int k = 0; k < 2; ++k) \
        acc[ai][bj][m][n] = __builtin_amdgcn_mfma_f32_16x16x32_bf16(Bt[n][k], At[m][k], acc[ai][bj][m][n], 0, 0, 0); __builtin_amdgcn_s_setprio(0); } while (0)
#define PG8_WAIT_V(n) asm volatile("s_waitcnt vmcnt(" #n ")" ::: "memory")
#define PG8_WAIT_L(n) asm volatile("s_waitcnt lgkmcnt(" #n ")" ::: "memory")
#define PG8_BAR __builtin_amdgcn_s_barrier()
#define PG8_SCHED __builtin_amdgcn_sched_barrier(0)
    Unit cur, nxt; int ui = 0;
    if (!S.next(0, cur)) return;
    f32x4 acc[2][2][4][2];
#pragma unroll
    for (int a = 0; a < 2; ++a)
#pragma unroll
        for (int b = 0; b < 2; ++b)
#pragma unroll
            for (int m = 0; m < 4; ++m)
#pragma unroll
                for (int n = 0; n < 2; ++n) acc[a][b][m][n] = (f32x4){0.f, 0.f, 0.f, 0.f};
    bf16x8 At[4][2], B0[2][2], B1[2][2];
    const char* cA = (const char*)g.A + (size_t)cur.pm * tstep; const char* cB = (const char*)g.Bt + (size_t)cur.pn * tstep;
    S.a_ready(cur);
    if constexpr (SP2) {
        PG8_STAGE(PG8_SB(0, 0), cB, voffB); PG8_STAGE(PG8_SB(0, 1), cB + hstep, voffB); PG8_STAGE(PG8_SA(0, 0), cA, voffA); PG8_STAGE(PG8_SA(0, 1), cA + hstep, voffA);
        if (wr == 1) PG8_BAR;
        PG8_WAIT_V(2); PG8_BAR;
        PG8_STAGE(PG8_SB(1, 0), cB + kstep, voffB); PG8_STAGE(PG8_SA(1, 0), cA + kstep, voffA); PG8_STAGE(PG8_SB(1, 1), cB + hstep + kstep, voffB);
        PG8_WAIT_V(6); PG8_BAR;
    } else {
        PG8_STAGE(PG8_SB(0, 0), cB, voffB); PG8_STAGE(PG8_SA(0, 0), cA, voffA); PG8_STAGE(PG8_SB(0, 1), cB + hstep, voffB); PG8_STAGE(PG8_SA(0, 1), cA + hstep, voffA);
        if (wr == 1) PG8_BAR;
        PG8_WAIT_V(4); PG8_BAR;
        PG8_STAGE(PG8_SB(1, 0), cB + kstep, voffB); PG8_STAGE(PG8_SA(1, 0), cA + kstep, voffA); PG8_STAGE(PG8_SB(1, 1), cB + hstep + kstep, voffB);
        PG8_WAIT_V(6); PG8_BAR;
    }
    for (;;) {
        const bool has_next = S.next(ui + 1, nxt);
        const char* nA = has_next ? (const char*)g.A + (size_t)nxt.pm * tstep : cA; const char* nB = has_next ? (const char*)g.Bt + (size_t)nxt.pn * tstep : cB;
        for (int t = 0; t < nt; t += 2) {
            const bool last = (t == nt - 2);
            const char* a1 = cA + (size_t)(t + 1) * kstep;
            const char* a2 = last ? nA : cA + (size_t)(t + 2) * kstep; const char* b2 = last ? nB : cB + (size_t)(t + 2) * kstep;
            const char* a3 = a2 + kstep; const char* b3 = b2 + kstep;
            if (last && has_next) S.a_ready(nxt);
            if constexpr (SP2) {
            PG8_LDB(B0, 0, 0); PG8_LDB(B1, 0, 1); PG8_SCHED; PG8_LDA(At, 0, 0); PG8_STAGE(PG8_SA(1, 1), a1 + hstep, voffA);
            PG8_WAIT_V(8); PG8_WAIT_L(0); PG8_BAR; PG8_MMA(0, 0, At, B0); PG8_MMA(0, 1, At, B1); PG8_BAR; PG8_SCHED;
            PG8_LDA(At, 0, 1); PG8_STAGE(PG8_SB(0, 0), b2, voffB); PG8_STAGE(PG8_SB(0, 1), b2 + hstep, voffB); PG8_STAGE(PG8_SA(0, 0), a2, voffA);
            PG8_WAIT_V(8); PG8_WAIT_L(0); PG8_BAR; PG8_MMA(1, 0, At, B0); PG8_MMA(1, 1, At, B1); PG8_BAR; PG8_SCHED;
            PG8_LDB(B0, 1, 0); PG8_LDB(B1, 1, 1); PG8_SCHED; PG8_LDA(At, 1, 0); PG8_STAGE(PG8_SA(0, 1), a2 + hstep, voffA);
            PG8_WAIT_V(8); PG8_WAIT_L(0); PG8_BAR; PG8_MMA(0, 0, At, B0); PG8_MMA(0, 1, At, B1); PG8_BAR; PG8_SCHED;
            PG8_LDA(At, 1, 1); PG8_STAGE(PG8_SB(1, 0), b3, voffB); PG8_STAGE(PG8_SB(1, 1), b3 + hstep, voffB); PG8_STAGE(PG8_SA(1, 0), a3, voffA);
            PG8_WAIT_V(8); PG8_WAIT_L(0); PG8_BAR; PG8_MMA(1, 0, At, B0); PG8_MMA(1, 1, At, B1); PG8_BAR; PG8_SCHED;
            } else {
            PG8_LDB(B0, 0, 0); PG8_SCHED; PG8_LDA(At, 0, 0); PG8_STAGE(PG8_SA(1, 1), a1 + hstep, voffA);
            PG8_WAIT_L(8); PG8_BAR; PG8_WAIT_L(0); PG8_MMA(0, 0, At, B0); PG8_BAR; PG8_SCHED;
            PG8_LDB(B1, 0, 1); PG8_STAGE(PG8_SB(0, 0), b2, voffB);
            PG8_BAR; PG8_WAIT_L(0); PG8_MMA(0, 1, At, B1); PG8_BAR;
            PG8_LDA(At, 0, 1); PG8_STAGE(PG8_SA(0, 0), a2, voffA);
            PG8_BAR; PG8_WAIT_L(0); PG8_MMA(1, 0, At, B0); PG8_BAR; PG8_SCHED;
            PG8_STAGE(PG8_SB(0, 1), b2 + hstep, voffB);
            PG8_WAIT_V(6); PG8_BAR; PG8_MMA(1, 1, At, B1); PG8_BAR;
            PG8_LDB(B0, 1, 0); PG8_SCHED; PG8_LDA(At, 1, 0); PG8_STAGE(PG8_SA(0, 1), a2 + hstep, voffA);
            PG8_WAIT_L(8); PG8_BAR; PG8_WAIT_L(0); PG8_MMA(0, 0, At, B0); PG8_BAR; PG8_SCHED;
            PG8_LDB(B1, 1, 1); PG8_STAGE(PG8_SB(1, 0), b3, voffB);
            PG8_BAR; PG8_WAIT_L(0); PG8_MMA(0, 1, At, B1); PG8_BAR;
            PG8_LDA(At, 1, 1); PG8_STAGE(PG8_SA(1, 0), a3, voffA);
            PG8_BAR; PG8_WAIT_L(0); PG8_MMA(1, 0, At, B0); PG8_BAR; PG8_SCHED;
            PG8_STAGE(PG8_SB(1, 1), b3 + hstep, voffB);
            PG8_WAIT_V(6); PG8_BAR; PG8_MMA(1, 1, At, B1); PG8_BAR;
            }
        }
        if constexpr (ALIGN_EPI) { if (wr == 0) PG8_BAR; }
        if constexpr (!Epi::AFTER_DRAIN) { E(acc, cur, wr, wc, fr, fq); S.done(cur); }
        if (!has_next) break;
#pragma unroll
        for (int a = 0; a < 2; ++a)
#pragma unroll
            for (int b = 0; b < 2; ++b)
#pragma unroll
                for (int m = 0; m < 4; ++m)
#pragma unroll
                    for (int n = 0; n < 2; ++n) acc[a][b][m][n] = (f32x4){0.f, 0.f, 0.f, 0.f};
        cur = nxt; cA = nA; cB = nB; ++ui;
        if constexpr (ALIGN_EPI) { if (wr == 1) PG8_BAR; }
    }
    PG8_WAIT_V(0);
    if constexpr (!ALIGN_EPI) { if (wr == 0) PG8_BAR; }
    PG8_BAR;
    if constexpr (Epi::AFTER_DRAIN) { E.fused(acc, cur, wr, wc, fr, fq, lds, wid, lane); S.done(cur); }
#undef PG8_SA
#undef PG8_SB
#undef PG8_STAGE
#undef PG8_LDA
#undef PG8_LDB
#undef PG8_MMA
#undef PG8_WAIT_V
#undef PG8_WAIT_L
#undef PG8_BAR
#undef PG8_SCHED
}
}

constexpr int NWAVES = 8;
constexpr int T = 16384, D = 1024, INW = 5640, N1 = 5632;
constexpr int NPH = 15;
#ifndef MK_PER_PHASE
#define MK_PER_PHASE 0
#endif
constexpr size_t MiB = 1u << 20;
constexpr size_t WS_CTL = 0, CTL_ZERO_BYTES = 1 * MiB;
constexpr size_t WS_WIN = 2 * MiB;
constexpr size_t WS_WUA = 13 * MiB;
constexpr size_t WS_WUM = 14 * MiB;
constexpr size_t WS_WOUT = 15 * MiB;
constexpr size_t WS_WPG = 17 * MiB;
constexpr size_t WS_WPP = 19 * MiB;
constexpr size_t WS_XBARP = 20 * MiB;
constexpr size_t WS_KMEAN = 21 * MiB;
constexpr size_t WS_IF = 21 * MiB + 512 * 1024;
constexpr size_t WS_SEL = 22 * MiB;
constexpr size_t WS_BLAST = 22 * MiB + 512 * 1024;
constexpr size_t WS_MLOC = WS_BLAST + 4096;
constexpr size_t WS_MST = WS_MLOC + 4096;
constexpr size_t WS_NLOC = 23 * MiB;
constexpr size_t WS_NST = 23 * MiB + 256 * 1024;
constexpr size_t WS_PML = 24 * MiB;
constexpr size_t WS_RE = 28 * MiB;
constexpr size_t WS_RW = WS_RE + 128 * 1024;
constexpr size_t WS_TSLOT = WS_RW + 128 * 1024;
constexpr size_t WS_ROWW = WS_TSLOT + 128 * 1024;
constexpr size_t WS_CNT = WS_ROWW + 160 * 1024;
constexpr size_t WS_BLKE = WS_CNT + 32 * 1024;
constexpr size_t WS_WRT = 29 * MiB;
constexpr size_t WS_PB = 30 * MiB;
constexpr size_t WS_XN = 40 * MiB;
constexpr size_t WS_QC = 40 * MiB, WS_KC = 56 * MiB;
constexpr size_t WS_O7 = 72 * MiB;
constexpr size_t WS_AQ = 72 * MiB, WS_AK = 88 * MiB, WS_AV = 104 * MiB, WS_MQ = 120 * MiB, WS_MK = 136 * MiB, WS_MV = 152 * MiB, WS_MO = 168 * MiB;
constexpr size_t WS_GA = 184 * MiB, WS_GM = 216 * MiB;
constexpr size_t WS_KCT = 248 * MiB, WS_VT = 264 * MiB, WS_AVT = 280 * MiB;
constexpr size_t WS_KVLOC = 120 * MiB;
constexpr size_t WS_CT = 152 * MiB;
#if defined(MK_DEBUG)
constexpr size_t WS_YA = 40 * MiB, WS_YM = 88 * MiB;
#else
constexpr size_t WS_YA = 72 * MiB, WS_YM = 88 * MiB;
#endif
constexpr size_t WS_T1 = 120 * MiB, WS_MERGED = 152 * MiB;
constexpr size_t WS_XS = 72 * MiB;
constexpr size_t WS_HID = 152 * MiB;
constexpr size_t WS_YB = 72 * MiB;
constexpr size_t WS_WEUP = 200 * MiB;
constexpr size_t WS_WEDN = 264 * MiB;
constexpr size_t WS_PJ = 152 * MiB;
constexpr size_t WS_END = 296 * MiB;
constexpr int CW_BAR = 4096;
constexpr int CW_QUEUE = 16384;
constexpr int LDS_BYTES = 163840;
constexpr int MISC_OFF = 163840 - 256;

#define GAS __attribute__((address_space(1)))
#define LAS __attribute__((address_space(3)))
typedef unsigned short bf16;
typedef unsigned v4u __attribute__((ext_vector_type(4)));
typedef unsigned v2u __attribute__((ext_vector_type(2)));
typedef float f32x4 __attribute__((ext_vector_type(4)));
typedef float f32x2 __attribute__((ext_vector_type(2)));
typedef short bf16x8 __attribute__((ext_vector_type(8)));
typedef GAS unsigned gu32;
#define RLX_AGENT __ATOMIC_RELAXED, __HIP_MEMORY_SCOPE_AGENT
#define LDS_WAIT() asm volatile("s_waitcnt lgkmcnt(0)" ::: "memory")
#define VM_WAIT() asm volatile("s_waitcnt vmcnt(0)" ::: "memory")
typedef float f32x2_t __attribute__((ext_vector_type(2)));
typedef __bf16 bf16x2_t __attribute__((ext_vector_type(2)));
__device__ __forceinline__ unsigned pk2(float lo, float hi) { const f32x2_t v = {lo, hi}; const bf16x2_t b = __builtin_convertvector(v, bf16x2_t); return __builtin_bit_cast(unsigned, b); }
__device__ __forceinline__ float bflo(unsigned w) { return __uint_as_float(w << 16); }
__device__ __forceinline__ float bfhi(unsigned w) { return __uint_as_float(w & 0xffff0000u); }
__device__ __forceinline__ float sigm(float x) { return __builtin_amdgcn_rcpf(1.0f + __expf(-x)); }
__device__ __forceinline__ float wave_sum(float v) {
#pragma unroll
    for (int o = 1; o < 64; o <<= 1) v += __shfl_xor(v, o);
    return v;
}
__device__ __forceinline__ float wave_max(float v) {
#pragma unroll
    for (int o = 1; o < 64; o <<= 1) v = fmaxf(v, __shfl_xor(v, o));
    return v;
}
#define XB_TMO      128
#define XB_XCNT(j)  (256  + 64 * (j))
#define XB_XSUB(j)  (1280 + 64 * (j))
#define XB_XGEN(j)  (2304 + 64 * (j))
#define XB_TOP      3328
#define XB_TOPGEN   3392
#define XCD_BAR_WORDS 3456
#define XB_SPIN_CAP (1u << 18)

__device__ __forceinline__ unsigned xb_ld(unsigned* p)              { return __hip_atomic_load(p, __ATOMIC_RELAXED, __HIP_MEMORY_SCOPE_AGENT); }
__device__ __forceinline__ unsigned xb_add(unsigned* p, unsigned v) { return __hip_atomic_fetch_add(p, v, __ATOMIC_RELAXED, __HIP_MEMORY_SCOPE_AGENT); }
__device__ __forceinline__ unsigned xb_xcc_id() { return (unsigned)__builtin_amdgcn_s_getreg((3 << 11) | 20) & 0xFu; }
#define XB_SPIN(cond, bar) do { unsigned _sp = 0; while (cond) { __builtin_amdgcn_s_sleep(1); \
    if ((++_sp & 255u) == 0u) { if (xb_ld(&(bar)[XB_TMO])) break; if (_sp > XB_SPIN_CAP) { atomicAdd(&(bar)[XB_TMO], 1u); break; } } } } while (0)

struct XcdBarrier {
    unsigned* bar; unsigned x;
    volatile LAS unsigned* st;
};

__device__ __forceinline__ XcdBarrier xcd_barrier_post(unsigned* bar, volatile LAS unsigned* st) {
    XcdBarrier b; b.bar = bar; b.x = xb_xcc_id(); b.st = st;
    if (threadIdx.x == 0) (void)xb_add(&bar[XB_XCNT(b.x)], 1u);
    return b;
}
__device__ __forceinline__ void xcd_barrier_complete(unsigned* bar, unsigned x, unsigned& nloc, unsigned& nx) {
    const unsigned G = gridDim.x * gridDim.y * gridDim.z;
    unsigned sum, cnt, mine, sp = 0u;
    for (;;) {
        sum = 0u; cnt = 0u; mine = 0u;
#pragma unroll
        for (unsigned j = 0; j < 16; ++j) { const unsigned c = xb_ld(&bar[XB_XCNT(j)]); sum += c; cnt += (c > 0u) ? 1u : 0u; mine = (j == x) ? c : mine; }
        if (sum == G) break;
        __builtin_amdgcn_s_sleep(1);
        if ((++sp & 255u) == 0u) { if (xb_ld(&bar[XB_TMO])) break; if (sp > XB_SPIN_CAP) { atomicAdd(&bar[XB_TMO], 1u); break; } }
    }
    nloc = mine > 0u ? mine : 1u; nx = cnt > 0u ? cnt : 1u;
}

__device__ __forceinline__ void xcd_barrier(const XcdBarrier& b) {
    asm volatile("s_waitcnt vmcnt(0)" ::: "memory");
    __syncthreads();
    if (threadIdx.x == 0) {
        unsigned* bar = b.bar;
        __builtin_amdgcn_s_waitcnt(0);
        unsigned nloc = b.st[0], nx = b.st[1];
        if (nloc == 0u) { xcd_barrier_complete(bar, b.x, nloc, nx); b.st[0] = nloc; b.st[1] = nx; }
        const unsigned old = xb_add(&bar[XB_XSUB(b.x)], 1u);
        const unsigned gen = old / nloc;
        if (old + 1u == (gen + 1u) * nloc) {
            __builtin_amdgcn_fence(__ATOMIC_RELEASE, "agent");
            asm volatile("s_waitcnt vmcnt(0)" ::: "memory");
            const unsigned og = xb_add(&bar[XB_TOP], 1u);
            const unsigned tg = og / nx;
            if (og + 1u == (tg + 1u) * nx) xb_add(&bar[XB_TOPGEN], 1u);
            else XB_SPIN(xb_ld(&bar[XB_TOPGEN]) == tg, bar);
            __builtin_amdgcn_fence(__ATOMIC_ACQUIRE, "agent");
            xb_add(&bar[XB_XGEN(b.x)], 1u);
            asm volatile("s_waitcnt vmcnt(0)" ::: "memory");
        } else {
            XB_SPIN(xb_ld(&bar[XB_XGEN(b.x)]) == gen, bar);
            __builtin_amdgcn_fence(__ATOMIC_ACQUIRE, "agent");
            asm volatile("s_waitcnt vmcnt(0)" ::: "memory");
        }
    }
    __syncthreads();
}

struct Frame {
    LAS unsigned char* lds;
    volatile LAS unsigned* MISC;
    gu32* ctl;
    unsigned char* ws;
    int tid, lane, wave, vcu, G;
    const float* const* in;
    float* out;
};
enum { I_X = 0, I_P, I_MIXG, I_WIN, I_BGATE, I_CONVW, I_CONVB, I_IFB, I_MNG, I_WUA, I_WUM, I_WOUT, I_FFNG, I_RGW, I_RGB, I_REW, I_REB, I_EWG, I_EWU, I_EWD, I_PLEG, I_WPG, I_WPP, I_FING };

__device__ __forceinline__ void transpose_item(const float* W, int ldw, int src_col0, bf16* WT, int K, int dst_row0, LAS float* scr, int kb, int nb, int lane) {
    (void)scr;
    const int k0 = 64 * kb + 8 * (lane >> 3), n0 = 32 * nb + 4 * (lane & 7);
    const GAS float* src = (const GAS float*)W + (size_t)k0 * ldw + src_col0 + n0;
    f32x4 v[8];
#pragma unroll
    for (int i = 0; i < 8; ++i) v[i] = *(const GAS f32x4*)(src + (size_t)i * ldw);
    GAS bf16* dst = (GAS bf16*)WT + (size_t)(dst_row0 + n0) * K + k0;
#pragma unroll
    for (int e = 0; e < 4; ++e) { v4u o; o.x = pk2(v[0][e], v[1][e]); o.y = pk2(v[2][e], v[3][e]); o.z = pk2(v[4][e], v[5][e]); o.w = pk2(v[6][e], v[7][e]); *(GAS v4u*)(dst + (size_t)e * K) = o; }
}

__device__ __forceinline__ void p0_prologue(Frame& F) {
    if (blockIdx.x == 0 && F.tid < 4) __hip_atomic_store(F.ctl + CW_QUEUE + 64 * F.tid, 0u, RLX_AGENT);
    LAS float* scr = (LAS float*)(F.lds + F.wave * 16384);
    const int gw = F.vcu * NWAVES + F.wave, NGW = F.G * NWAVES;
    constexpr int I_IN = 16 * (N1 / 32), I_UA = 8 * 32, I_UM = 8 * 32, I_OUT = 16 * 32, I_PG = 16 * 32, I_PP = 4 * 32;
    constexpr int NITEMS = I_IN + I_UA + I_UM + I_OUT + I_PG + I_PP;
    for (int it = gw; it < NITEMS; it += NGW) {
        int r = it;
        if (r < I_IN) { const int nb = r % (N1 / 32), kb = r / (N1 / 32); const int sc0 = (nb * 32 >= 3584) ? 8 : 0;
            transpose_item(F.in[I_WIN], INW, sc0, (bf16*)(F.ws + WS_WIN), 1024, 0, scr, kb, nb, F.lane); continue; } r -= I_IN;
        if (r < I_UA) { transpose_item(F.in[I_WUA], 1024, 0, (bf16*)(F.ws + WS_WUA), 512, 0, scr, r / 32, r % 32, F.lane); continue; } r -= I_UA;
        if (r < I_UM) { transpose_item(F.in[I_WUM], 1024, 0, (bf16*)(F.ws + WS_WUM), 512, 0, scr, r / 32, r % 32, F.lane); continue; } r -= I_UM;
        if (r < I_OUT) { transpose_item(F.in[I_WOUT], 1024, 0, (bf16*)(F.ws + WS_WOUT), 1024, 0, scr, r / 32, r % 32, F.lane); continue; } r -= I_OUT;
        if (r < I_PG) { transpose_item(F.in[I_WPG], 1024, 0, (bf16*)(F.ws + WS_WPG), 1024, 0, scr, r / 32, r % 32, F.lane); continue; } r -= I_PG;
        transpose_item(F.in[I_WPP], 1024, 0, (bf16*)(F.ws + WS_WPP), 256, 0, scr, r / 32, r % 32, F.lane);
    }
    { const int gi = F.vcu * (NWAVES * 64) + F.tid;
      if (gi < 48 * 1024) { const int c = gi >> 10, k = gi & 1023; const float w = c < 4 ? F.in[I_RGW][k * 4 + c] : c < 36 ? F.in[I_REW][k * 32 + (c - 4)] : 0.f;
          const unsigned hi = pk2(w, 0.f) & 0xffffu; const float r = w - bflo(hi);
          bf16* WRT = (bf16*)(F.ws + WS_WRT); WRT[gi] = (bf16)hi; WRT[48 * 1024 + gi] = (bf16)(pk2(r, 0.f) & 0xffffu); } }
    __syncthreads();
    LAS float* wif = (LAS float*)F.lds; LAS float* csum = (LAS float*)(F.lds + 32768);
    for (int idx = F.tid; idx < 8192; idx += NWAVES * 64) wif[(idx & 7) * 1024 + (idx >> 3)] = F.in[I_WIN][(size_t)(idx >> 3) * INW + 3584 + (idx & 7)];
    __syncthreads();
    const float* x = F.in[I_X]; const float* gain = F.in[I_MIXG]; bf16* XN = (bf16*)(F.ws + WS_XN); float* IFB = (float*)(F.ws + WS_IF);
    f32x4 gv[4], cs[4];
#pragma unroll
    for (int j = 0; j < 4; ++j) { gv[j] = *(const f32x4*)(gain + 4 * F.lane + 256 * j); cs[j] = (f32x4){0.f, 0.f, 0.f, 0.f}; }
    for (int i = 0; i < 8; ++i) {
        const int row = 64 * F.vcu + 8 * F.wave + i;
        const GAS f32x4* xr = (const GAS f32x4*)(x + (size_t)row * D) + F.lane;
        f32x4 v[4]; float ss = 0.f;
#pragma unroll
        for (int j = 0; j < 4; ++j) { v[j] = xr[64 * j]; ss += (v[j].x * v[j].x + v[j].y * v[j].y) + (v[j].z * v[j].z + v[j].w * v[j].w); }
        const float rs = 1.0f / sqrtf(wave_sum(ss) * (1.f / D) + 1e-6f);
        GAS unsigned long long* o8 = (GAS unsigned long long*)(XN + (size_t)row * D) + F.lane;
        float dt[8];
#pragma unroll
        for (int c = 0; c < 8; ++c) dt[c] = 0.f;
#pragma unroll
        for (int j = 0; j < 4; ++j) { v[j] = v[j] * rs * gv[j]; cs[j] += v[j];
            o8[64 * j] = (unsigned long long)pk2(v[j].x, v[j].y) | ((unsigned long long)pk2(v[j].z, v[j].w) << 32);
#pragma unroll
            for (int c = 0; c < 8; ++c) { const f32x4 w4 = *(const LAS f32x4*)(wif + c * 1024 + 4 * F.lane + 256 * j); dt[c] += (v[j].x * w4.x + v[j].y * w4.y) + (v[j].z * w4.z + v[j].w * w4.w); } }
#pragma unroll
        for (int c = 0; c < 8; ++c) dt[c] = wave_sum(dt[c]);
        if (F.lane == 0) { const float* ifb = F.in[I_IFB];
            *(f32x4*)(IFB + (size_t)row * 8) = (f32x4){dt[0] + ifb[0], dt[1] + ifb[1], dt[2] + ifb[2], dt[3] + ifb[3]};
            *(f32x4*)(IFB + (size_t)row * 8 + 4) = (f32x4){dt[4] + ifb[4], dt[5] + ifb[5], dt[6] + ifb[6], dt[7] + ifb[7]}; }
        { const f32x4 pv = *((const GAS f32x4*)(F.in[I_P] + (size_t)row * 256) + F.lane);
          *((GAS unsigned long long*)((bf16*)(F.ws + WS_PB) + (size_t)row * 256) + F.lane) = (unsigned long long)pk2(pv.x, pv.y) | ((unsigned long long)pk2(pv.z, pv.w) << 32); }
    }
#pragma unroll
    for (int j = 0; j < 4; ++j) *(LAS f32x4*)(csum + F.wave * 1024 + 4 * F.lane + 256 * j) = cs[j];
    __syncthreads();
    for (int c = F.tid; c < 1024; c += NWAVES * 64) { float s = 0.f;
#pragma unroll
        for (int w = 0; w < 8; ++w) s += csum[w * 1024 + c];
        ((float*)(F.ws + WS_XBARP))[(size_t)F.vcu * 1024 + c] = s; }
    __syncthreads();
}

__device__ __forceinline__ void p1_kmean(Frame& F) {
    LAS float* xb = (LAS float*)F.lds; LAS float* part = (LAS float*)(F.lds + 4096);
    const int j = F.vcu >> 2, c0 = (F.vcu & 3) * 128; const float* XP = (const float*)(F.ws + WS_XBARP);
    for (int k = F.tid; k < 1024; k += NWAVES * 64) xb[k] = (XP[(size_t)(4 * j) * 1024 + k] + XP[(size_t)(4 * j + 1) * 1024 + k] + XP[(size_t)(4 * j + 2) * 1024 + k] + XP[(size_t)(4 * j + 3) * 1024 + k]) * (1.0f / 256.0f);
    __syncthreads();
    const int col = c0 + (F.tid & 127), pt = F.tid >> 7; const float* wp = F.in[I_WIN] + 512 + col; float s = 0.f;
    for (int k = pt * 256; k < pt * 256 + 256; ++k) s += xb[k] * wp[(size_t)k * INW];
    part[pt * 128 + (F.tid & 127)] = s;
    __syncthreads();
    if (F.tid < 128) { const float r = part[F.tid] + part[128 + F.tid] + part[256 + F.tid] + part[384 + F.tid]; ((float*)(F.ws + WS_KMEAN))[((col >> 6) * 64 + j) * 64 + (col & 63)] = r; }
    __syncthreads();
}

__device__ __forceinline__ float bfe(const v4u& q, int e) { const unsigned w = q[e >> 1]; return (e & 1) ? bfhi(w) : bflo(w); }
__device__ __forceinline__ void layout_tile(Frame& F, int kind, int tt, int cc) {
    const int r8 = F.lane >> 3, ch = F.lane & 7, c0 = cc * 64 + ch * 8, t0 = tt * 64 + r8 * 8;
    const bf16* src = (const bf16*)(F.ws + (kind == 0 ? WS_MQ : kind == 1 ? WS_MK : kind == 2 ? WS_MV : WS_AV));
    float v[8][8];
    if (kind < 2) {
        const float* cw = F.in[I_CONVW] + (kind == 1 ? 512 : 0) + c0; const float* cb = F.in[I_CONVB] + (kind == 1 ? 512 : 0) + c0;
        float w[4][8], b[8];
#pragma unroll
        for (int k = 0; k < 4; ++k) { const f32x4 a = *(const f32x4*)(cw + k * 1024), c = *(const f32x4*)(cw + k * 1024 + 4); w[k][0] = a.x; w[k][1] = a.y; w[k][2] = a.z; w[k][3] = a.w; w[k][4] = c.x; w[k][5] = c.y; w[k][6] = c.z; w[k][7] = c.w; }
        { const f32x4 a = *(const f32x4*)cb, c = *(const f32x4*)(cb + 4); b[0] = a.x; b[1] = a.y; b[2] = a.z; b[3] = a.w; b[4] = c.x; b[5] = c.y; b[6] = c.z; b[7] = c.w; }
        v4u xp[11];
#pragma unroll
        for (int i = 0; i < 11; ++i) { const int t = t0 - 3 + i; xp[i] = (v4u){0u, 0u, 0u, 0u}; if (t >= 0) xp[i] = *(const GAS v4u*)(src + (size_t)t * 512 + c0); }
        const float osc = kind == 1 ? 0.08838834764831845f : 1.0f;
#pragma unroll
        for (int i = 0; i < 8; ++i)
#pragma unroll
            for (int e = 0; e < 8; ++e) { const float y = b[e] + w[0][e] * bfe(xp[i], e) + w[1][e] * bfe(xp[i + 1], e) + w[2][e] * bfe(xp[i + 2], e) + w[3][e] * bfe(xp[i + 3], e); v[i][e] = y * sigm(y) * osc; }
        bf16* dst = (bf16*)(F.ws + (kind == 0 ? WS_QC : WS_KC));
#pragma unroll
        for (int i = 0; i < 8; ++i) { v4u o; o.x = pk2(v[i][0], v[i][1]); o.y = pk2(v[i][2], v[i][3]); o.z = pk2(v[i][4], v[i][5]); o.w = pk2(v[i][6], v[i][7]); *(GAS v4u*)(dst + (size_t)(t0 + i) * 512 + c0) = o; }
    } else {
#pragma unroll
        for (int i = 0; i < 8; ++i) { const v4u q = *(const GAS v4u*)(src + (size_t)(t0 + i) * 512 + c0);
            v[i][0] = bflo(q.x); v[i][1] = bfhi(q.x); v[i][2] = bflo(q.y); v[i][3] = bfhi(q.y); v[i][4] = bflo(q.z); v[i][5] = bfhi(q.z); v[i][6] = bflo(q.w); v[i][7] = bfhi(q.w); }
    }
    if (kind >= 1) {
        bf16* dt = (bf16*)(F.ws + (kind == 1 ? WS_KCT : kind == 2 ? WS_VT : WS_AVT));
#pragma unroll
        for (int e = 0; e < 8; ++e) { v4u o; o.x = pk2(v[0][e], v[1][e]); o.y = pk2(v[2][e], v[3][e]); o.z = pk2(v[4][e], v[5][e]); o.w = pk2(v[6][e], v[7][e]); *(GAS v4u*)(dt + (size_t)(c0 + e) * T + t0) = o; }
    }
}
__device__ __forceinline__ void p2_layout_select(Frame& F, const int parts = 3) {
    const int gw = F.vcu * NWAVES + F.wave;
    if (parts & 1) { const int tt = gw >> 3, cc = gw & 7; layout_tile(F, 0, tt, cc); layout_tile(F, 1, tt, cc); layout_tile(F, 2, tt, cc); layout_tile(F, 3, tt, cc); }
    if (!(parts & 2)) return;
    const int h = F.wave, cur = (64 * F.vcu) >> 8, fr = F.lane & 15, g = F.lane >> 4, njt = (cur + 15) >> 4;
    unsigned* SELp = (unsigned*)(F.ws + WS_SEL) + (size_t)h * T + 64 * F.vcu;
    if (cur == 0) { SELp[F.lane] = 0xffffffu; return; }
    bf16x8 ah[4][2], al[4][2];
    const float* km = (const float*)(F.ws + WS_KMEAN) + (size_t)h * 64 * 64;
#pragma unroll
    for (int jt = 0; jt < 4; ++jt)
#pragma unroll
        for (int kk = 0; kk < 2; ++kk) {
            f32x4 a0 = (f32x4){0.f, 0.f, 0.f, 0.f}, a1 = a0;
            if (jt < njt) { const float* pk = km + (size_t)(16 * jt + fr) * 64 + 32 * kk + 8 * g; a0 = *(const GAS f32x4*)pk; a1 = *(const GAS f32x4*)(pk + 4); }
            v4u hh; hh.x = pk2(a0.x, a0.y); hh.y = pk2(a0.z, a0.w); hh.z = pk2(a1.x, a1.y); hh.w = pk2(a1.z, a1.w);
            v4u ll; ll.x = pk2(a0.x - bflo(hh.x), a0.y - bfhi(hh.x)); ll.y = pk2(a0.z - bflo(hh.y), a0.w - bfhi(hh.y)); ll.z = pk2(a1.x - bflo(hh.z), a1.y - bfhi(hh.z)); ll.w = pk2(a1.z - bflo(hh.w), a1.w - bfhi(hh.w));
            ah[jt][kk] = __builtin_bit_cast(bf16x8, hh); al[jt][kk] = __builtin_bit_cast(bf16x8, ll); }
#pragma unroll 1
    for (int tt = 0; tt < 4; ++tt) {
        const int t = 64 * F.vcu + 16 * tt + fr;
        bf16x8 qf[2];
#pragma unroll
        for (int kk = 0; kk < 2; ++kk) qf[kk] = *(const GAS bf16x8*)((const bf16*)(F.ws + WS_AQ) + (size_t)t * 512 + h * 64 + 32 * kk + 8 * g);
        float b0 = -INFINITY, b1 = -INFINITY, b2 = -INFINITY; int i0 = 255, i1 = 255, i2 = 255;
#pragma unroll
        for (int jt = 0; jt < 4; ++jt) {
            if (jt < njt) {
                f32x4 c = (f32x4){0.f, 0.f, 0.f, 0.f};
#pragma unroll
                for (int kk = 0; kk < 2; ++kk) { c = __builtin_amdgcn_mfma_f32_16x16x32_bf16(ah[jt][kk], qf[kk], c, 0, 0, 0); c = __builtin_amdgcn_mfma_f32_16x16x32_bf16(al[jt][kk], qf[kk], c, 0, 0, 0); }
#pragma unroll
                for (int r = 0; r < 4; ++r) { const int j = 16 * jt + 4 * g + r; const float s = j < cur ? c[r] : -INFINITY;
                    if (s > b0) { b2 = b1; i2 = i1; b1 = b0; i1 = i0; b0 = s; i0 = j; } else if (s > b1) { b2 = b1; i2 = i1; b1 = s; i1 = j; } else if (s > b2) { b2 = s; i2 = j; } }
            }
        }
#pragma unroll
        for (int o = 16; o <= 32; o <<= 1) {
            const float p0 = __shfl_xor(b0, o), p1 = __shfl_xor(b1, o), p2 = __shfl_xor(b2, o); const int q0 = __shfl_xor(i0, o), q1 = __shfl_xor(i1, o), q2 = __shfl_xor(i2, o);
#define SEL_INS(s, j) do { const float s_ = (s); const int j_ = (j); \
            if (s_ > b0 || (s_ == b0 && j_ < i0)) { b2 = b1; i2 = i1; b1 = b0; i1 = i0; b0 = s_; i0 = j_; } \
            else if (s_ > b1 || (s_ == b1 && j_ < i1)) { b2 = b1; i2 = i1; b1 = s_; i1 = j_; } \
            else if (s_ > b2 || (s_ == b2 && j_ < i2)) { b2 = s_; i2 = j_; } } while (0)
            SEL_INS(p0, q0); SEL_INS(p1, q1); SEL_INS(p2, q2);
#undef SEL_INS
        }
        if (b1 == -INFINITY) i1 = 255; if (b2 == -INFINITY) i2 = 255;
        if (g == 0) SELp[16 * tt + fr] = (unsigned)i0 | ((unsigned)i1 << 8) | ((unsigned)i2 << 16);
    }
}

constexpr int A_KS = 0, A_KROW = 144, A_VS = 36864, A_VROW = 528, A_LIST = 70656, A_MLS = 81920;
constexpr float LOG2E = 1.4426950408889634f;
#define MFMA16(a, b, c) __builtin_amdgcn_mfma_f32_16x16x32_bf16((a), (b), (c), 0, 0, 0)

__device__ __forceinline__ void attn_stage_kv(Frame& F, int h, int kbase) {
    const bf16* AK = (const bf16*)(F.ws + WS_AK); const bf16* AVT = (const bf16*)(F.ws + WS_AVT);
#pragma unroll
    for (int p = 0; p < 4; ++p) { const int idx = F.tid + 512 * p, row = idx >> 3, chk = idx & 7;
        *(LAS v4u*)(F.lds + A_KS + row * A_KROW + chk * 16) = *(const GAS v4u*)(AK + (size_t)(kbase + row) * 512 + h * 64 + chk * 8); }
#pragma unroll
    for (int p = 0; p < 4; ++p) { const int idx = F.tid + 512 * p, d = idx >> 5, chk = idx & 31;
        *(LAS v4u*)(F.lds + A_VS + d * A_VROW + chk * 16) = *(const GAS v4u*)(AVT + (size_t)(h * 64 + d) * T + kbase + chk * 8); }
}
__device__ __forceinline__ void attn_load_q(Frame& F, int h, int tq, bf16x8 (&qf)[2]) {
    const bf16* AQ = (const bf16*)(F.ws + WS_AQ);
#pragma unroll
    for (int kk = 0; kk < 2; ++kk) qf[kk] = *(const GAS bf16x8*)(AQ + (size_t)tq * 512 + h * 64 + kk * 32 + (F.lane >> 4) * 8);
}
template <bool CAUSAL> __device__ __forceinline__ void attn_tile(Frame& F, int h, int tq, const bf16x8 (&qf)[2], int nkt, int qrel, bool valid, int slot) {
    const int fr = F.lane & 15, g = F.lane >> 4;
    f32x4 s[16];
#pragma unroll
    for (int kt = 0; kt < 16; ++kt) {
        if (kt < nkt) {
            const LAS unsigned char* kp = F.lds + A_KS + (16 * kt + fr) * A_KROW + g * 16;
            const bf16x8 a0 = *(const LAS bf16x8*)kp, a1 = *(const LAS bf16x8*)(kp + 64);
            f32x4 c = (f32x4){0.f, 0.f, 0.f, 0.f}; c = MFMA16(a0, qf[0], c); c = MFMA16(a1, qf[1], c);
            if (CAUSAL) {
#pragma unroll
                for (int r = 0; r < 4; ++r) if (16 * kt + 4 * g + r > qrel) c[r] = -INFINITY;
            }
            s[kt] = c;
        } else s[kt] = (f32x4){-INFINITY, -INFINITY, -INFINITY, -INFINITY};
        if ((kt & 3) == 3) asm volatile("" ::: "memory");
    }
    float mx = -INFINITY;
#pragma unroll
    for (int kt = 0; kt < 16; ++kt) mx = fmaxf(fmaxf(fmaxf(s[kt][0], s[kt][1]), fmaxf(s[kt][2], s[kt][3])), mx);
    mx = fmaxf(mx, __shfl_xor(mx, 16)); mx = fmaxf(mx, __shfl_xor(mx, 32));
    float l = 0.f; bf16x8 pb[8];
#pragma unroll
    for (int i = 0; i < 8; ++i) {
        f32x4 p0, p1;
#pragma unroll
        for (int r = 0; r < 4; ++r) { p0[r] = __builtin_amdgcn_exp2f((s[2 * i][r] - mx) * LOG2E); p1[r] = __builtin_amdgcn_exp2f((s[2 * i + 1][r] - mx) * LOG2E); }
        l += (p0[0] + p0[1]) + (p0[2] + p0[3]) + (p1[0] + p1[1]) + (p1[2] + p1[3]);
        v4u w; w.x = pk2(p0[0], p0[1]); w.y = pk2(p0[2], p0[3]); w.z = pk2(p1[0], p1[1]); w.w = pk2(p1[2], p1[3]);
        pb[i] = __builtin_bit_cast(bf16x8, w);
    }
    l += __shfl_xor(l, 16); l += __shfl_xor(l, 32);
    f32x4 o[4];
#pragma unroll
    for (int dt = 0; dt < 4; ++dt) o[dt] = (f32x4){0.f, 0.f, 0.f, 0.f};
#pragma unroll
    for (int i = 0; i < 8; ++i) {
        if (2 * i < nkt) {
#pragma unroll
            for (int dt = 0; dt < 4; ++dt) {
                const LAS unsigned char* vp = F.lds + A_VS + (16 * dt + fr) * A_VROW + (32 * i + 4 * g) * 2;
                const v2u lo = *(const LAS v2u*)vp, hi = *(const LAS v2u*)(vp + 32);
                const v4u vv = (v4u){lo.x, lo.y, hi.x, hi.y};
                o[dt] = MFMA16(__builtin_bit_cast(bf16x8, vv), pb[i], o[dt]);
            }
        }
        if (i & 1) asm volatile("" ::: "memory");
    }
    if (valid) {
        bf16* PO = (bf16*)F.out + ((size_t)(tq * 8 + h) * 4 + slot) * 64;
#pragma unroll
        for (int dt = 0; dt < 4; ++dt) { v2u w; w.x = pk2(o[dt][0], o[dt][1]); w.y = pk2(o[dt][2], o[dt][3]); *(GAS v2u*)(PO + 16 * dt + 4 * g) = w; }
        if (g == 0) *(GAS f32x2*)((float*)(F.ws + WS_PML) + ((size_t)(tq * 8 + h) * 4 + slot) * 2) = (f32x2){mx, l};
    }
}
__device__ __forceinline__ void attn_item(Frame& F, int h, int j, int cl, int ch, bool diag) {
    attn_stage_kv(F, h, j * 256);
    LAS unsigned* LIST = (LAS unsigned*)(F.lds + A_LIST); LAS unsigned* cnt = (LAS unsigned*)(F.MISC + 17);
    if (F.tid == 0) *cnt = 0u;
    __syncthreads();
    const unsigned* SEL = (const unsigned*)(F.ws + WS_SEL) + (size_t)h * T;
    for (int t = 256 * cl + F.tid; t < 256 * ch; t += NWAVES * 64) {
        const unsigned w = SEL[t]; const int slot = ((w & 255u) == (unsigned)j) ? 0 : (((w >> 8) & 255u) == (unsigned)j) ? 1 : (((w >> 16) & 255u) == (unsigned)j) ? 2 : -1;
        if (slot >= 0) { const unsigned pos = __hip_atomic_fetch_add(cnt, 1u, __ATOMIC_RELAXED, __HIP_MEMORY_SCOPE_WORKGROUP); LIST[pos] = (unsigned)t | ((unsigned)slot << 16); } }
    bf16x8 qf[2], qn[2];
    if (diag) {
        const int qrel0 = F.wave * 16 + (F.lane & 15);
        attn_load_q(F, h, j * 256 + qrel0, qf); attn_load_q(F, h, j * 256 + 128 + qrel0, qn);
        attn_tile<true>(F, h, j * 256 + qrel0, qf, 8, qrel0, true, 3);
        attn_tile<true>(F, h, j * 256 + 128 + qrel0, qn, 16, 128 + qrel0, true, 3);
    }
    __syncthreads();
    const int n = __builtin_amdgcn_readfirstlane((int)*cnt), w16 = F.wave * 16;
    const int nw = n > w16 ? (n - w16 + 127) >> 7 : 0;
    unsigned e = 0u; bool valid = false;
    if (nw > 0) { const int idx = w16 + (F.lane & 15); valid = idx < n; e = LIST[valid ? idx : w16]; attn_load_q(F, h, (int)(e & 0xffffu), qf); }
#pragma unroll 1
    for (int tile = 0; tile < nw; ++tile) {
        unsigned en = 0u; bool vn = false;
        if (tile + 1 < nw) { const int idx = (tile + 1) * 128 + w16 + (F.lane & 15); vn = idx < n; en = LIST[vn ? idx : (tile + 1) * 128 + w16]; attn_load_q(F, h, (int)(en & 0xffffu), qn); }
        attn_tile<false>(F, h, (int)(e & 0xffffu), qf, 16, 0, valid, (int)(e >> 16));
        e = en; valid = vn; qf[0] = qn[0]; qf[1] = qn[1];
    }
    __syncthreads();
}
__device__ __forceinline__ float wave_scan_add(float v, int lane) {
#pragma unroll
    for (int o = 1; o < 64; o <<= 1) { const float y = __shfl_up(v, o); if (lane >= o) v += y; }
    return v;
}
__device__ __forceinline__ float wave_scan_max(float v, int lane) {
#pragma unroll
    for (int o = 1; o < 64; o <<= 1) { const float y = __shfl_up(v, o); if (lane >= o) v = fmaxf(v, y); }
    return v;
}
__device__ __forceinline__ float log_sigmoid(float x) { return fminf(x, 0.f) - log1pf(__expf(-fabsf(x))); }
__device__ __forceinline__ void mlstm_local_item(Frame& F, int h, int c) {
    const int t0 = c * 128, fr = F.lane & 15, g = F.lane >> 4, w = F.wave;
    const float* IFB = (const float*)(F.ws + WS_IF);
    const float li0 = IFB[(size_t)(t0 + 2 * F.lane) * 8 + h], li1 = IFB[(size_t)(t0 + 2 * F.lane + 1) * 8 + h];
    const float lf0 = log_sigmoid(IFB[(size_t)(t0 + 2 * F.lane) * 8 + 4 + h]), lf1 = log_sigmoid(IFB[(size_t)(t0 + 2 * F.lane + 1) * 8 + 4 + h]);
    const float P = wave_scan_add(lf0 + lf1, F.lane), bc1 = P, bc0 = P - lf1, blast = __shfl(P, 63);
    const float a0 = li0 - bc0, a1 = li1 - bc1, amax = wave_max(fmaxf(a0, a1));
    LAS float* wtab = (LAS float*)(F.lds + A_MLS + w * 2048);
    *(LAS f32x2*)(wtab + 2 * F.lane) = (f32x2){__expf(a0 - amax), __expf(a1 - amax)};
    LDS_WAIT(); asm volatile("" ::: "memory");
    const bf16* KCT = (const bf16*)(F.ws + WS_KCT); const bf16* VT = (const bf16*)(F.ws + WS_VT);
    f32x4 acc[8];
#pragma unroll
    for (int et = 0; et < 8; ++et) acc[et] = (f32x4){0.f, 0.f, 0.f, 0.f};
    float nsum = 0.f;
#pragma unroll
    for (int kk = 0; kk < 4; ++kk) {
        const v4u kc = *(const GAS v4u*)(KCT + (size_t)(h * 128 + 16 * w + fr) * T + t0 + 32 * kk + 8 * g);
        const f32x4 w0 = *(const LAS f32x4*)(wtab + 32 * kk + 8 * g), w1 = *(const LAS f32x4*)(wtab + 32 * kk + 8 * g + 4);
        const float k0 = bflo(kc.x) * w0.x, k1 = bfhi(kc.x) * w0.y, k2 = bflo(kc.y) * w0.z, k3 = bfhi(kc.y) * w0.w, k4 = bflo(kc.z) * w1.x, k5 = bfhi(kc.z) * w1.y, k6 = bflo(kc.w) * w1.z, k7 = bfhi(kc.w) * w1.w;
        nsum += ((k0 + k1) + (k2 + k3)) + ((k4 + k5) + (k6 + k7));
        v4u ap; ap.x = pk2(k0, k1); ap.y = pk2(k2, k3); ap.z = pk2(k4, k5); ap.w = pk2(k6, k7);
        const bf16x8 af = __builtin_bit_cast(bf16x8, ap);
#pragma unroll
        for (int et = 0; et < 8; ++et) { const bf16x8 bfv = *(const GAS bf16x8*)(VT + (size_t)(h * 128 + 16 * et + fr) * T + t0 + 32 * kk + 8 * g); acc[et] = MFMA16(af, bfv, acc[et]); }
    }
    float* KV = (float*)(F.ws + WS_KVLOC) + (size_t)(h * 128 + c) * 16384;
#pragma unroll
    for (int et = 0; et < 8; ++et) *(GAS f32x4*)(KV + (size_t)(16 * et + fr) * 128 + 16 * w + 4 * g) = acc[et];
    nsum += __shfl_xor(nsum, 16); nsum += __shfl_xor(nsum, 32);
    if (g == 0) ((float*)(F.ws + WS_NLOC))[(size_t)(h * 128 + c) * 128 + 16 * w + fr] = nsum;
    if (F.tid == 0) { ((float*)(F.ws + WS_BLAST))[h * 128 + c] = blast; ((float*)(F.ws + WS_MLOC))[h * 128 + c] = blast + amax; }
}
__device__ __forceinline__ int queue_pop(Frame& F, int q) {
    if (F.tid == 0) F.MISC[16] = __hip_atomic_fetch_add(F.ctl + CW_QUEUE + 64 * q, 1u, RLX_AGENT);
    __syncthreads();
    const int item = __builtin_amdgcn_readfirstlane((int)F.MISC[16]);
    __syncthreads();
    return item;
}
__device__ __forceinline__ void p3_attention(Frame& F, const int qb, const int parts = 7) {
    constexpr int N_JP = 4 * 3 + 13 * 2 + 46 + 1, N_A = N_JP * 8;
    if (parts & 1) {
#pragma unroll 1
        for (int item = queue_pop(F, qb); (unsigned)item < (unsigned)N_A; item = queue_pop(F, qb)) {
            const int jp = item >> 3, h = item & 7; int j, part, P;
            if (jp < 12) { j = jp / 3; part = jp - 3 * j; P = 3; } else if (jp < 38) { j = 4 + ((jp - 12) >> 1); part = (jp - 12) & 1; P = 2; } else { j = 17 + (jp - 38); part = 0; P = 1; }
            const float lr = __log2f(64.0f / (float)(j + 1));
            int cl = (part == 0) ? j + 1 : (int)((float)(j + 1) * __builtin_amdgcn_exp2f(lr * (float)part / (float)P) + 0.5f);
            int ch = (part == P - 1) ? 64 : (int)((float)(j + 1) * __builtin_amdgcn_exp2f(lr * (float)(part + 1) / (float)P) + 0.5f);
            cl = cl < j + 1 ? j + 1 : cl; ch = ch > 64 ? 64 : ch;
            attn_item(F, h, j, __builtin_amdgcn_readfirstlane(cl), __builtin_amdgcn_readfirstlane(ch), part == 0);
        }
    }
    if (parts & 4) {
#pragma unroll 1
        for (int k = 0; k < 2; ++k) { const int item = F.vcu * 2 + k; mlstm_local_item(F, item & 3, item >> 2); }
    }
}

#if defined(MK_DEBUG)
__device__ __forceinline__ void dbg_fill_sentinel(Frame& F) {
    float* PML = (float*)(F.ws + WS_PML) + (size_t)(64 * F.vcu) * 64;
    for (int i = F.tid; i < 4096; i += NWAVES * 64) PML[i] = 12345.0f;
}
__device__ __forceinline__ void dbg_check(Frame& F) {
    const float* PML = (const float*)(F.ws + WS_PML); const bf16* PO = (const bf16*)F.out;
    unsigned lost = 0, bad = 0;
    for (int i = F.tid; i < 64 * 8 * 4; i += NWAVES * 64) { const int tl = i >> 5, h = (i >> 2) & 7, k = i & 3, t = 64 * F.vcu + tl, cur = t >> 8, nv = cur < 3 ? cur : 3;
        if (k == 3 || k < nv) { const float m = PML[((size_t)(t * 8 + h) * 4 + k) * 2], l = PML[((size_t)(t * 8 + h) * 4 + k) * 2 + 1];
            if (m == 12345.0f) lost++; else { bool ok = (m == m) && (l == l) && fabsf(m) < 1e30f && l > 0.f && l < 1e30f;
                for (int d = 0; d < 64; ++d) { const float o = __uint_as_float((unsigned)PO[((size_t)(t * 8 + h) * 4 + k) * 64 + d] << 16); ok = ok && (o == o) && fabsf(o) < 1e30f; }
                if (!ok) bad++; } } }
    if (lost) __hip_atomic_fetch_add(F.ctl + CW_QUEUE + 64 * 4, lost, RLX_AGENT);
    if (bad) __hip_atomic_fetch_add(F.ctl + CW_QUEUE + 64 * 5, bad, RLX_AGENT);
}
__device__ __forceinline__ void dbg_attn_check(Frame& F) {
    const bf16* AQ = (const bf16*)(F.ws + WS_AQ); const bf16* AK = (const bf16*)(F.ws + WS_AK); const bf16* AV = (const bf16*)(F.ws + WS_AV); const bf16* YA = (const bf16*)(F.ws + WS_YA);
    const int t = 64 * F.vcu + 8 * F.wave + 3, cur = t >> 8; unsigned mism = 0;
    for (int h = 0; h < 8; ++h) {
        const unsigned w = ((const unsigned*)(F.ws + WS_SEL))[(size_t)h * T + t];
        {
          float gj = -INFINITY; if (F.lane < cur) { gj = 0.f; const float* km = (const float*)(F.ws + WS_KMEAN) + ((size_t)h * 64 + F.lane) * 64; for (int d = 0; d < 64; ++d) gj += __uint_as_float((unsigned)AQ[(size_t)t * 512 + h * 64 + d] << 16) * km[d]; }
          const float m1 = wave_max(gj); float v1 = gj == m1 ? -INFINITY : gj; const float m2 = wave_max(v1); float v2 = v1 == m2 ? -INFINITY : v1; const float m3 = wave_max(v2);
          const float th = (cur >= 3 ? m3 : -INFINITY); int nvalid = 0;
          for (int k = 0; k < 3; ++k) { const int sidx = (int)((w >> (8 * k)) & 255u); if (sidx != 255) { nvalid++; const float gs = __shfl(gj, sidx & 63); if (!(sidx < cur) || !(gs >= th - 2e-5f)) mism++; } }
          if (nvalid != (cur < 3 ? cur : 3)) mism++; }
        int blk[4] = {(int)(w & 255u), (int)((w >> 8) & 255u), (int)((w >> 16) & 255u), cur};
        float sc[16]; float mx = -INFINITY;
        for (int b = 0; b < 4; ++b) for (int i = 0; i < 4; ++i) { const int key = F.lane + 64 * i; float s = -INFINITY;
            const bool ok = (b == 3) ? (blk[3] * 256 + key <= t) : (blk[b] < cur);
            if (ok) { s = 0.f; const int kt = blk[b] * 256 + key; for (int d = 0; d < 64; ++d) s += __uint_as_float((unsigned)AQ[(size_t)t * 512 + h * 64 + d] << 16) * __uint_as_float((unsigned)AK[(size_t)kt * 512 + h * 64 + d] << 16); }
            sc[b * 4 + i] = s; mx = fmaxf(mx, s); }
        mx = wave_max(mx); float l = 0.f;
        for (int q = 0; q < 16; ++q) { sc[q] = __expf(sc[q] - mx); l += sc[q]; }
        l = wave_sum(l);
        for (int d = 0; d < 64; ++d) { float o = 0.f;
            for (int b = 0; b < 4; ++b) for (int i = 0; i < 4; ++i) { const float p = sc[b * 4 + i]; if (p > 0.f) { const int kt = blk[b] * 256 + F.lane + 64 * i; o += p * __uint_as_float((unsigned)AV[(size_t)kt * 512 + h * 64 + d] << 16); } }
            o = wave_sum(o) / l; const float ya = __uint_as_float((unsigned)YA[(size_t)t * 512 + h * 64 + d] << 16);
            if (!(fabsf(ya - o) <= 0.02f * fabsf(o) + 0.004f)) mism++; } }
    if (F.lane == 0 && mism) __hip_atomic_fetch_add(F.ctl + CW_QUEUE + 64 * 5, mism, RLX_AGENT);
}
__device__ __forceinline__ void dbg_report(Frame& F) {
    const unsigned lost = __hip_atomic_load(F.ctl + CW_QUEUE + 64 * 4, RLX_AGENT), bad = __hip_atomic_load(F.ctl + CW_QUEUE + 64 * 5, RLX_AGENT);
    const float v = 100.0f + (lost ? 1000.0f : 0.f) + (bad ? 30000.0f : 0.f) + (lost > 1000u ? 200.f : 0.f) + (bad > 1000u ? 5000.f : 0.f);
    for (int i = F.tid; i < 64 * 1024; i += NWAVES * 64) F.out[(size_t)(64 * F.vcu) * 1024 + i] = v;
}
#endif

#if defined(MK_DUMP)
__device__ __forceinline__ void dbg_dump_bf16(Frame& F, size_t ws_off, int ld, int ncols) {
    const bf16* src = (const bf16*)(F.ws + ws_off);
    for (int i = F.tid; i < 64 * 1024; i += NWAVES * 64) { const int t = 64 * F.vcu + (i >> 10), c = i & 1023; F.out[(size_t)t * 1024 + c] = c < ncols ? __uint_as_float((unsigned)src[(size_t)t * ld + c] << 16) : 0.f; }
}
#endif
__device__ __forceinline__ void p4_scan_combine(Frame& F) {
    if (F.vcu < 132) {
        const int h = F.vcu < 128 ? (F.vcu >> 5) : (F.vcu - 128);
        LAS float* dec = (LAS float*)F.lds; LAS float* scl = (LAS float*)(F.lds + 512);
        if (F.wave == 0) {
            const float* BL = (const float*)(F.ws + WS_BLAST) + h * 128; const float* ML = (const float*)(F.ws + WS_MLOC) + h * 128; float* MS = (float*)(F.ws + WS_MST) + h * 128;
            const float bl0 = BL[2 * F.lane], bl1 = BL[2 * F.lane + 1], ml0 = ML[2 * F.lane], ml1 = ML[2 * F.lane + 1];
            const float P = wave_scan_add(bl0 + bl1, F.lane), B1 = P - bl1, B2 = P;
            const float g0 = ml0 - B1, g1 = ml1 - B2;
            const float PM = wave_scan_max(fmaxf(g0, g1), F.lane); float ex = __shfl_up(PM, 1); if (F.lane == 0) ex = -INFINITY;
            const float mn0 = B1 + fmaxf(0.f, fmaxf(ex, g0)), mn1 = B2 + fmaxf(0.f, PM);
            float mp1 = __shfl_up(mn1, 1); if (F.lane == 0) mp1 = 0.f;
            const float m0 = mp1, m1 = mn0;
            *(LAS f32x2*)(dec + 2 * F.lane) = (f32x2){__expf(bl0 + m0 - mn0), __expf(bl1 + m1 - mn1)};
            *(LAS f32x2*)(scl + 2 * F.lane) = (f32x2){__expf(ml0 - mn0), __expf(ml1 - mn1)};
            if ((F.vcu & 31) == 0 && F.vcu < 128) { MS[2 * F.lane] = m0; MS[2 * F.lane + 1] = m1; } }
        __syncthreads();
        if (F.vcu < 128) {
            const int e = 4 * (F.vcu & 31) + (F.tid >> 7), d = F.tid & 127;
            const float* KV = (const float*)(F.ws + WS_KVLOC) + (size_t)h * 128 * 16384 + e * 128 + d; bf16* CT = (bf16*)(F.ws + WS_CT) + (size_t)h * 128 * 16384 + e * 128 + d;
            float C = 0.f;
#pragma unroll 1
            for (int c0 = 0; c0 < 128; c0 += 32) { float kv[32];
#pragma unroll
                for (int i = 0; i < 32; ++i) kv[i] = KV[(size_t)(c0 + i) * 16384];
#pragma unroll
                for (int i = 0; i < 32; ++i) { CT[(size_t)(c0 + i) * 16384] = (bf16)(pk2(C, 0.f) & 0xffffu); C = dec[c0 + i] * C + scl[c0 + i] * kv[i]; } }
        } else if (F.tid < 128) {
            const float* NL = (const float*)(F.ws + WS_NLOC) + (size_t)h * 16384 + F.tid; float* NS = (float*)(F.ws + WS_NST) + (size_t)h * 16384 + F.tid;
            float n = 0.f;
#pragma unroll 8
            for (int c = 0; c < 128; ++c) { const float nl = NL[c * 128]; NS[c * 128] = n; n = dec[c] * n + scl[c] * nl; }
        }
        __syncthreads();
    }
    const int gw = F.vcu * NWAVES + F.wave; const int h = F.lane >> 3, d8 = (F.lane & 7) * 8;
    const float* PML = (const float*)(F.ws + WS_PML); const bf16* PO = (const bf16*)F.out; bf16* YA = (bf16*)(F.ws + WS_YA);
    for (int i = 0; i < 8; ++i) {
        const int t = gw * 8 + i, cur = t >> 8, nv = cur < 3 ? cur : 3;
        float m[4], l[4]; float M = -INFINITY;
#pragma unroll
        for (int k = 0; k < 4; ++k) { const bool ok = (k == 3) || (k < nv); m[k] = -INFINITY; l[k] = 0.f;
            if (ok) { const f32x2 ml = *(const GAS f32x2*)(PML + ((size_t)(t * 8 + h) * 4 + k) * 2); m[k] = ml.x; l[k] = ml.y; } M = fmaxf(M, m[k]); }
        float o[8]; float L = 0.f;
#pragma unroll
        for (int e = 0; e < 8; ++e) o[e] = 0.f;
#pragma unroll
        for (int k = 0; k < 4; ++k) { const bool ok = (k == 3) || (k < nv);
            if (ok) { const float wk = __builtin_amdgcn_exp2f((m[k] - M) * LOG2E); L += wk * l[k]; const v4u q = *(const GAS v4u*)(PO + ((size_t)(t * 8 + h) * 4 + k) * 64 + d8);
                o[0] += wk * bflo(q.x); o[1] += wk * bfhi(q.x); o[2] += wk * bflo(q.y); o[3] += wk * bfhi(q.y); o[4] += wk * bflo(q.z); o[5] += wk * bfhi(q.z); o[6] += wk * bflo(q.w); o[7] += wk * bfhi(q.w); } }
        const float inv = 1.0f / L; v4u r; r.x = pk2(o[0] * inv, o[1] * inv); r.y = pk2(o[2] * inv, o[3] * inv); r.z = pk2(o[4] * inv, o[5] * inv); r.w = pk2(o[6] * inv, o[7] * inv);
        *(GAS v4u*)(YA + (size_t)t * 512 + h * 64 + d8) = r;
    }
}

__device__ __forceinline__ void mlstm_out_item(Frame& F, int h, int c) {
    const int t0 = c * 128, fr = F.lane & 15, g = F.lane >> 4, w = F.wave;
    const float* IFB = (const float*)(F.ws + WS_IF);
    const float li0 = IFB[(size_t)(t0 + 2 * F.lane) * 8 + h], li1 = IFB[(size_t)(t0 + 2 * F.lane + 1) * 8 + h];
    const float lf0 = log_sigmoid(IFB[(size_t)(t0 + 2 * F.lane) * 8 + 4 + h]), lf1 = log_sigmoid(IFB[(size_t)(t0 + 2 * F.lane + 1) * 8 + 4 + h]);
    const float P = wave_scan_add(lf0 + lf1, F.lane), bc1 = P, bc0 = P - lf1;
    const float a0 = li0 - bc0, a1 = li1 - bc1;
    const float PM = wave_scan_max(fmaxf(a0, a1), F.lane); float ex = __shfl_up(PM, 1); if (F.lane == 0) ex = -INFINITY;
    const float pm0 = fmaxf(ex, a0), pm1 = PM;
    LAS float* atab = (LAS float*)(F.lds + A_MLS + w * 2048); LAS float* btab = atab + 128; LAS float* ptab = atab + 256;
    *(LAS f32x2*)(atab + 2 * F.lane) = (f32x2){a0, a1}; *(LAS f32x2*)(btab + 2 * F.lane) = (f32x2){bc0, bc1}; *(LAS f32x2*)(ptab + 2 * F.lane) = (f32x2){pm0, pm1};
    LDS_WAIT(); asm volatile("" ::: "memory");
    const int tl = 16 * w + fr;
    const float mcar = ((const float*)(F.ws + WS_MST))[h * 128 + c];
    const float bt = btab[tl], inter = bt + mcar, mt = fmaxf(inter, bt + ptab[tl]), sci = __expf(inter - mt), ct = bt - mt;
    const bf16* QC = (const bf16*)(F.ws + WS_QC); const bf16* KC = (const bf16*)(F.ws + WS_KC); const bf16* VT = (const bf16*)(F.ws + WS_VT); const bf16* CT = (const bf16*)(F.ws + WS_CT) + (size_t)(h * 128 + c) * 16384;
    bf16x8 qf[4];
#pragma unroll
    for (int kk = 0; kk < 4; ++kk) qf[kk] = *(const GAS bf16x8*)(QC + (size_t)(t0 + tl) * 512 + h * 128 + 32 * kk + 8 * g);
    float qn = 0.f; { const float* NS = (const float*)(F.ws + WS_NST) + (size_t)(h * 128 + c) * 128;
#pragma unroll
        for (int kk = 0; kk < 4; ++kk) { const v4u q = __builtin_bit_cast(v4u, qf[kk]); const f32x4 n0 = *(const GAS f32x4*)(NS + 32 * kk + 8 * g), n1 = *(const GAS f32x4*)(NS + 32 * kk + 8 * g + 4);
            qn += bflo(q.x) * n0.x + bfhi(q.x) * n0.y + bflo(q.y) * n0.z + bfhi(q.y) * n0.w + bflo(q.z) * n1.x + bfhi(q.z) * n1.y + bflo(q.w) * n1.z + bfhi(q.w) * n1.w; } }
    qn += __shfl_xor(qn, 16); qn += __shfl_xor(qn, 32);
    float dsum = 0.f; v2u pw[8];
#pragma unroll
    for (int st = 0; st < 8; ++st) {
        pw[st] = (v2u){0u, 0u};
        if (st <= w) {
            f32x4 s = (f32x4){0.f, 0.f, 0.f, 0.f};
#pragma unroll
            for (int kk = 0; kk < 4; ++kk) { const bf16x8 kf = *(const GAS bf16x8*)(KC + (size_t)(t0 + 16 * st + fr) * 512 + h * 128 + 32 * kk + 8 * g); s = MFMA16(kf, qf[kk], s); }
            const f32x4 av = *(const LAS f32x4*)(atab + 16 * st + 4 * g);
#pragma unroll
            for (int r = 0; r < 4; ++r) { const float wgt = (16 * st + 4 * g + r <= tl) ? __expf(av[r] + ct) : 0.f; s[r] *= wgt; }
            dsum += (s[0] + s[1]) + (s[2] + s[3]);
            pw[st].x = pk2(s[0], s[1]); pw[st].y = pk2(s[2], s[3]);
        }
    }
    dsum += __shfl_xor(dsum, 16); dsum += __shfl_xor(dsum, 32);
    f32x4 aI[8], aC[8];
#pragma unroll
    for (int et = 0; et < 8; ++et) { aI[et] = (f32x4){0.f, 0.f, 0.f, 0.f}; aC[et] = (f32x4){0.f, 0.f, 0.f, 0.f}; }
#pragma unroll
    for (int i = 0; i < 4; ++i) {
        if (2 * i <= w) {
            const v4u pv = (v4u){pw[2 * i].x, pw[2 * i].y, pw[2 * i + 1].x, pw[2 * i + 1].y}; const bf16x8 pb = __builtin_bit_cast(bf16x8, pv);
#pragma unroll
            for (int et = 0; et < 8; ++et) { const bf16* vp = VT + (size_t)(h * 128 + 16 * et + fr) * T + t0 + 32 * i + 4 * g;
                const v2u lo = *(const GAS v2u*)vp, hi = *(const GAS v2u*)(vp + 16); const v4u vv = (v4u){lo.x, lo.y, hi.x, hi.y};
                aI[et] = MFMA16(__builtin_bit_cast(bf16x8, vv), pb, aI[et]); }
        }
    }
#pragma unroll
    for (int kk = 0; kk < 4; ++kk)
#pragma unroll
        for (int et = 0; et < 8; ++et) { const bf16x8 cf = *(const GAS bf16x8*)(CT + (size_t)(16 * et + fr) * 128 + 32 * kk + 8 * g); aC[et] = MFMA16(cf, qf[kk], aC[et]); }
    const float den = dsum + sci * qn, dn = fmaxf(fabsf(den), __expf(-mt)), rden = 1.0f / dn;
    const bf16* MO = (const bf16*)(F.ws + WS_MO) + (size_t)(t0 + tl) * 512 + h * 128; const float* gn = F.in[I_MNG] + h * 128;
    float ss = 0.f;
#pragma unroll
    for (int et = 0; et < 8; ++et) { const v2u mo = *(const GAS v2u*)(MO + 16 * et + 4 * g);
        const float o0 = sigm(bflo(mo.x)), o1 = sigm(bfhi(mo.x)), o2 = sigm(bflo(mo.y)), o3 = sigm(bfhi(mo.y));
        f32x4 hv = (aI[et] + aC[et] * sci) * rden; hv[0] *= o0; hv[1] *= o1; hv[2] *= o2; hv[3] *= o3; aI[et] = hv;
        ss += (hv[0] * hv[0] + hv[1] * hv[1]) + (hv[2] * hv[2] + hv[3] * hv[3]); }
    ss += __shfl_xor(ss, 16); ss += __shfl_xor(ss, 32);
    const float rs = 1.0f / sqrtf(ss * (1.0f / 128.0f) + 1e-6f);
    bf16* YM = (bf16*)(F.ws + WS_YM) + (size_t)(t0 + tl) * 512 + h * 128;
#pragma unroll
    for (int et = 0; et < 8; ++et) { const f32x4 gg = *(const f32x4*)(gn + 16 * et + 4 * g); v2u o; o.x = pk2(aI[et][0] * rs * gg.x, aI[et][1] * rs * gg.y); o.y = pk2(aI[et][2] * rs * gg.z, aI[et][3] * rs * gg.w);
        *(GAS v2u*)(YM + 16 * et + 4 * g) = o; }
}
__device__ __forceinline__ void p5_mlstm_out(Frame& F) {
#pragma unroll 1
    for (int k = 0; k < 2; ++k) { const int item = F.vcu * 2 + k; mlstm_out_item(F, item & 3, item >> 2); }
}

__device__ __forceinline__ void p8_convert(Frame& F) {
    { LAS float* scr = (LAS float*)(F.lds + F.wave * 16384); const int gw = F.vcu * NWAVES + F.wave, NGW = F.G * NWAVES;
      for (int it = gw; it < 16384 + 8192; it += NGW) {
          if (it < 16384) { const int nb = it & 3, kb = (it >> 2) & 15, gu = (it >> 6) & 1, j = (it >> 7) & 3, e = it >> 9;
              transpose_item(F.in[gu ? I_EWU : I_EWG] + (size_t)e * 1024 * 512, 512, j * 128, (bf16*)(F.ws + WS_WEUP), 1024, (e * 4 + j) * 256 + gu * 128, scr, kb, nb, F.lane); }
          else { const int r = it - 16384, nb = r & 31, kb = (r >> 5) & 7, e = r >> 8;
              transpose_item(F.in[I_EWD] + (size_t)e * 512 * 1024, 1024, 0, (bf16*)(F.ws + WS_WEDN), 512, e * 1024, scr, kb, nb, F.lane); } } }
}
__device__ __forceinline__ void p8_route(Frame& F) {
    LAS float* rsv = (LAS float*)F.lds; LAS float* LG = (LAS float*)(F.lds + 1024);
    if (F.tid < 32) F.MISC[32 + F.tid] = 0u;
    const float* gain = F.in[I_FFNG]; bf16* XN = (bf16*)(F.ws + WS_XN);
    { f32x4 gv[4];
#pragma unroll
      for (int j = 0; j < 4; ++j) gv[j] = *(const f32x4*)(gain + 4 * F.lane + 256 * j);
#pragma unroll 2
      for (int i = 0; i < 8; ++i) {
        const int row = 64 * F.vcu + 8 * F.wave + i;
        const GAS f32x4* xr = (const GAS f32x4*)(F.out + (size_t)row * D) + F.lane;
        f32x4 v[4]; float ss = 0.f;
#pragma unroll
        for (int j = 0; j < 4; ++j) { v[j] = xr[64 * j]; ss += (v[j].x * v[j].x + v[j].y * v[j].y) + (v[j].z * v[j].z + v[j].w * v[j].w); }
        const float rs = 1.0f / sqrtf(wave_sum(ss) * (1.f / D) + 1e-6f);
        GAS unsigned long long* o8 = (GAS unsigned long long*)(XN + (size_t)row * D) + F.lane;
#pragma unroll
        for (int j = 0; j < 4; ++j) { const f32x4 q = v[j] * rs * gv[j]; o8[64 * j] = (unsigned long long)pk2(q.x, q.y) | ((unsigned long long)pk2(q.z, q.w) << 32); }
        if (F.lane == 0) rsv[8 * F.wave + i] = rs;
      } }
    __syncthreads();
    { const int rt = F.wave & 3, kh = F.wave >> 2, xr = F.lane & 15, g = F.lane >> 4, row = 64 * F.vcu + 16 * rt + xr;
      const float rs = rsv[16 * rt + xr]; const bf16* WH = (const bf16*)(F.ws + WS_WRT); const bf16* WL = WH + 48 * 1024;
      f32x4 acc[3];
#pragma unroll
      for (int ct = 0; ct < 3; ++ct) acc[ct] = (f32x4){0.f, 0.f, 0.f, 0.f};
#pragma unroll 2
      for (int kk = 0; kk < 16; ++kk) { const int k0 = 512 * kh + 32 * kk + 8 * g;
          const f32x4 a0 = *(const GAS f32x4*)(F.out + (size_t)row * D + k0), a1 = *(const GAS f32x4*)(F.out + (size_t)row * D + k0 + 4);
          const f32x4 g0 = *(const f32x4*)(gain + k0), g1 = *(const f32x4*)(gain + k0 + 4);
          const f32x4 x0 = a0 * rs * g0, x1 = a1 * rs * g1;
          v4u hh; hh.x = pk2(x0.x, x0.y); hh.y = pk2(x0.z, x0.w); hh.z = pk2(x1.x, x1.y); hh.w = pk2(x1.z, x1.w);
          v4u ll; ll.x = pk2(x0.x - bflo(hh.x), x0.y - bfhi(hh.x)); ll.y = pk2(x0.z - bflo(hh.y), x0.w - bfhi(hh.y)); ll.z = pk2(x1.x - bflo(hh.z), x1.y - bfhi(hh.z)); ll.w = pk2(x1.z - bflo(hh.w), x1.w - bfhi(hh.w));
          const bf16x8 xh = __builtin_bit_cast(bf16x8, hh), xl = __builtin_bit_cast(bf16x8, ll);
#pragma unroll
          for (int ct = 0; ct < 3; ++ct) { const bf16x8 wh = *(const GAS bf16x8*)(WH + (size_t)(16 * ct + xr) * 1024 + k0), wl = *(const GAS bf16x8*)(WL + (size_t)(16 * ct + xr) * 1024 + k0);
              acc[ct] = MFMA16(wh, xh, acc[ct]); acc[ct] = MFMA16(wl, xh, acc[ct]); acc[ct] = MFMA16(wh, xl, acc[ct]); } }
#pragma unroll
      for (int ct = 0; ct < 3; ++ct) *(LAS f32x4*)(LG + (size_t)(kh * 64 + 16 * rt + xr) * 48 + 16 * ct + 4 * g) = acc[ct]; }
    __syncthreads();
    if (F.tid < 64) {
        const int row = 64 * F.vcu + F.tid; const LAS float* l0 = LG + F.tid * 48; const LAS float* l1 = LG + (64 + F.tid) * 48;
        const float* rgb = F.in[I_RGB]; const float* reb = F.in[I_REB];
        float gl[4]; int grp = 0; float gmx;
#pragma unroll
        for (int c = 0; c < 4; ++c) gl[c] = l0[c] + l1[c] + rgb[c];
        gmx = gl[0];
#pragma unroll
        for (int c = 1; c < 4; ++c) if (gl[c] > gmx) { gmx = gl[c]; grp = c; }
        float gz = 0.f;
#pragma unroll
        for (int c = 0; c < 4; ++c) gz += __expf(gl[c] - gmx);
        const float pgrp = 1.0f / gz;
        float el[8];
#pragma unroll
        for (int c = 0; c < 8; ++c) el[c] = l0[4 + grp * 8 + c] + l1[4 + grp * 8 + c] + reb[grp * 8 + c];
        int i1 = 0; float m1 = el[0];
#pragma unroll
        for (int c = 1; c < 8; ++c) if (el[c] > m1) { m1 = el[c]; i1 = c; }
        int i2 = -1; float m2 = -INFINITY;
#pragma unroll
        for (int c = 0; c < 8; ++c) if (c != i1 && el[c] > m2) { m2 = el[c]; i2 = c; }
        const float e2 = __expf(m2 - m1), w1 = pgrp / (1.0f + e2), w2 = pgrp * e2 / (1.0f + e2);
        int* RE = (int*)(F.ws + WS_RE); float* RW = (float*)(F.ws + WS_RW);
        RE[row * 2] = grp * 8 + i1; RE[row * 2 + 1] = grp * 8 + i2; RW[row * 2] = w1; RW[row * 2 + 1] = w2;
        __hip_atomic_fetch_add((LAS unsigned*)(F.MISC + 32 + grp * 8 + i1), 1u, __ATOMIC_RELAXED, __HIP_MEMORY_SCOPE_WORKGROUP);
        __hip_atomic_fetch_add((LAS unsigned*)(F.MISC + 32 + grp * 8 + i2), 1u, __ATOMIC_RELAXED, __HIP_MEMORY_SCOPE_WORKGROUP);
    }
    __syncthreads();
    if (F.tid < 32) ((int*)(F.ws + WS_CNT))[F.vcu * 32 + F.tid] = (int)F.MISC[32 + F.tid];
    __syncthreads();
}

__device__ __forceinline__ void p9_permute(Frame& F) {
    LAS int* pt = (LAS int*)F.lds; LAS int* pp = pt + 512; LAS int* tot = pt + 1024; LAS int* pre = pt + 1056; LAS int* poff = pt + 1088; LAS int* es = pt + 1152; LAS int* sl = pt + 1280;
    const int* CNT = (const int*)(F.ws + WS_CNT);
    { const int e = F.tid & 31, part = F.tid >> 5; int s = 0, p = 0;
      for (int wg = part * 16; wg < part * 16 + 16; ++wg) { const int c = CNT[wg * 32 + e]; s += c; if (wg < F.vcu) p += c; }
      pt[part * 32 + e] = s; pp[part * 32 + e] = p; }
    __syncthreads();
    if (F.tid < 32) { int s = 0, p = 0; for (int q = 0; q < 16; ++q) { s += pt[q * 32 + F.tid]; p += pp[q * 32 + F.tid]; } tot[F.tid] = s; pre[F.tid] = p; }
    __syncthreads();
    if (F.tid == 0) { int off = 0; for (int e = 0; e < 32; ++e) { poff[e] = off; off += ((tot[e] + 255) >> 8) << 8; } poff[32] = off; }
    const int* RE = (const int*)(F.ws + WS_RE); const float* RW = (const float*)(F.ws + WS_RW);
    if (F.tid < 128) es[F.tid] = RE[(64 * F.vcu) * 2 + F.tid];
    __syncthreads();
    if (F.tid < 128) { const int e = es[F.tid]; int rank = 0; for (int q = 0; q < F.tid; ++q) rank += (es[q] == e) ? 1 : 0;
        const int slot = poff[e] + pre[e] + rank; sl[F.tid] = slot;
        ((int*)(F.ws + WS_TSLOT))[(64 * F.vcu) * 2 + F.tid] = slot; ((float*)(F.ws + WS_ROWW))[slot] = RW[(64 * F.vcu) * 2 + F.tid]; }
    __syncthreads();
    const bf16* XN = (const bf16*)(F.ws + WS_XN); bf16* XS = (bf16*)(F.ws + WS_XS);
#pragma unroll 4
    for (int q = 0; q < 16; ++q) { const int i = 16 * F.wave + q, t = 64 * F.vcu + (i >> 1), slot = sl[i];
        const GAS v4u* s = (const GAS v4u*)(XN + (size_t)t * 1024); GAS v4u* d = (GAS v4u*)(XS + (size_t)slot * 1024);
        d[F.lane] = s[F.lane]; d[F.lane + 64] = s[F.lane + 64]; }
    if (F.vcu < 32) { const int e = F.vcu; for (int s = poff[e] + tot[e] + F.tid; s < poff[e + 1]; s += NWAVES * 64) ((float*)(F.ws + WS_ROWW))[s] = 0.f; }
    if (F.vcu == 0) { int* BLKE = (int*)(F.ws + WS_BLKE);
        if (F.tid < 160) { int e = 0; for (int q = 0; q < 32; ++q) if (256 * F.tid >= poff[q + 1]) e = q + 1; BLKE[F.tid] = e < 32 ? e : 0; }
        if (F.tid == 0) BLKE[192] = poff[32] >> 8; }
    __syncthreads();
}

__device__ __forceinline__ void p12_combine(Frame& F) {
    const float* gain = F.in[I_PLEG]; bf16* XN = (bf16*)(F.ws + WS_XN); const bf16* YB = (const bf16*)(F.ws + WS_YB); const int* TS = (const int*)(F.ws + WS_TSLOT);
    f32x4 gv[4];
#pragma unroll
    for (int j = 0; j < 4; ++j) gv[j] = *(const f32x4*)(gain + 4 * F.lane + 256 * j);
#pragma unroll 1
    for (int i = 0; i < 8; ++i) {
        const int row = 64 * F.vcu + 8 * F.wave + i; const int s0 = TS[row * 2], s1 = TS[row * 2 + 1];
        GAS f32x4* xr = (GAS f32x4*)(F.out + (size_t)row * D) + F.lane;
        const GAS v2u* y0 = (const GAS v2u*)(YB + (size_t)s0 * 1024) + F.lane; const GAS v2u* y1 = (const GAS v2u*)(YB + (size_t)s1 * 1024) + F.lane;
        f32x4 v[4]; float ss = 0.f;
#pragma unroll
        for (int j = 0; j < 4; ++j) { v[j] = xr[64 * j]; const v2u a = y0[64 * j], b = y1[64 * j];
            v[j].x += bflo(a.x) + bflo(b.x); v[j].y += bfhi(a.x) + bfhi(b.x); v[j].z += bflo(a.y) + bflo(b.y); v[j].w += bfhi(a.y) + bfhi(b.y);
            xr[64 * j] = v[j]; ss += (v[j].x * v[j].x + v[j].y * v[j].y) + (v[j].z * v[j].z + v[j].w * v[j].w); }
        const float rs = 1.0f / sqrtf(wave_sum(ss) * (1.f / D) + 1e-6f);
        GAS unsigned long long* o8 = (GAS unsigned long long*)(XN + (size_t)row * D) + F.lane;
#pragma unroll
        for (int j = 0; j < 4; ++j) { const f32x4 q = v[j] * rs * gv[j]; o8[64 * j] = (unsigned long long)pk2(q.x, q.y) | ((unsigned long long)pk2(q.z, q.w) << 32); }
    }
}
__device__ __forceinline__ void p14_final(Frame& F) {
    const float* gain = F.in[I_FING];
    f32x4 gv[4];
#pragma unroll
    for (int j = 0; j < 4; ++j) gv[j] = *(const f32x4*)(gain + 4 * F.lane + 256 * j);
#pragma unroll 1
    for (int i = 0; i < 8; ++i) {
        const int row = 64 * F.vcu + 8 * F.wave + i;
        GAS f32x4* xr = (GAS f32x4*)(F.out + (size_t)row * D) + F.lane;
        f32x4 v[4]; float ss = 0.f;
#pragma unroll
        for (int j = 0; j < 4; ++j) { v[j] = xr[64 * j]; ss += (v[j].x * v[j].x + v[j].y * v[j].y) + (v[j].z * v[j].z + v[j].w * v[j].w); }
        const float rs = 1.0f / sqrtf(wave_sum(ss) * (1.f / D) + 1e-6f);
#pragma unroll
        for (int j = 0; j < 4; ++j) xr[64 * j] = v[j] * rs * gv[j];
    }
}

struct Args { const float* in[24]; float* out; unsigned char* ws; int ph_lo, ph_hi; };
__global__ void __launch_bounds__(NWAVES * 64, 2) mk_fwd(Args args) {
    extern __shared__ __attribute__((aligned(16))) unsigned char lds[];
    Frame F;
    F.lds = (LAS unsigned char*)lds;
    F.MISC = (volatile LAS unsigned*)(F.lds + MISC_OFF);
    F.wave = __builtin_amdgcn_readfirstlane((int)threadIdx.x >> 6); F.lane = (int)__builtin_amdgcn_mbcnt_hi(~0u, __builtin_amdgcn_mbcnt_lo(~0u, 0u)); F.tid = F.wave * 64 + F.lane;
    F.G = gridDim.x; { const int bx = blockIdx.x; F.vcu = (F.G % 8 == 0) ? (bx % 8) * (F.G / 8) + bx / 8 : bx; }
    F.ws = args.ws; F.ctl = (gu32*)(args.ws + WS_CTL); F.out = args.out;
    F.in = args.in;
    for (int u = F.tid; u < (LDS_BYTES - MISC_OFF) / 4; u += NWAVES * 64) ((LAS unsigned*)(F.lds + MISC_OFF))[u] = 0u;
    __syncthreads();
#if MK_PER_PHASE
#define GRID_BAR() do { } while (0)
#else
    const XcdBarrier bar = xcd_barrier_post((unsigned*)(F.ctl + CW_BAR), F.MISC + 8);
#define GRID_BAR() xcd_barrier(bar)
#endif
    const int lo = args.ph_lo, hi = args.ph_hi;
#ifndef MK_MASK
#define MK_MASK 0x7fff
#endif
#define IN(k) (((MK_MASK >> (k)) & 1) && lo <= (k) && (k) < hi)
#ifndef MK_DUP
#define MK_DUP -1
#endif
#define REP(k) for (int rep_ = 0; rep_ < ((k) == MK_DUP ? 2 : 1); ++rep_)
#if defined(MK_TSA)
#define STAMP(k) do { if (blockIdx.x == 0 && threadIdx.x == 0) ((unsigned long long*)(F.ws + 512 * 1024))[(k) + 1] = __builtin_amdgcn_s_memrealtime(); } while (0)
#else
#define STAMP(k) do { } while (0)
#endif
#define SEAM(k) do { if (IN(k) && IN((k) + 1)) GRID_BAR(); STAMP(k); } while (0)
    bf16* const XN = (bf16*)(F.ws + WS_XN);
    STAMP(-1);

#define FRESH() do { int l_; asm volatile("v_mbcnt_lo_u32_b32 %0, -1, 0\n\tv_mbcnt_hi_u32_b32 %0, -1, %0" : "=v"(l_)); F.lane = l_; F.tid = F.wave * 64 + l_; } while (0)
    if (IN(0)) { REP(0) { FRESH(); p0_prologue(F); if (MK_DUP == 0) GRID_BAR(); } } SEAM(0);
    if (IN(1)) REP(1) {
        FRESH(); p1_kmean(F);
        pg8::Gemm g{XN, (const bf16*)(F.ws + WS_WIN), T, N1, 1024}; pg8::StaticOrder S; S.init(T, N1, F.G, (int)blockIdx.x);
        pg8::EpiG1 E{(bf16*)(F.ws + WS_O7), (bf16*)(F.ws + WS_GA), F.in[I_BGATE]};
        pg8::gemm_phase<pg8::EpiG1, pg8::StaticOrder, true, true>(F.lds, g, S, E, F.wave);
    } SEAM(1);
    if (MK_DUP == 99) { for (int b_ = 0; b_ < 8; ++b_) GRID_BAR(); }
    if (IN(2)) { REP(2) { FRESH(); p2_layout_select(F); if (MK_DUP == 2) GRID_BAR(); }
        if (MK_DUP >= 20 && MK_DUP <= 21) { GRID_BAR(); FRESH(); p2_layout_select(F, 1 << (MK_DUP - 20)); }
#if defined(MK_DEBUG)
        dbg_fill_sentinel(F); if (blockIdx.x == 0 && F.tid < 2) __hip_atomic_store(F.ctl + CW_QUEUE + 64 * (4 + F.tid), 0u, RLX_AGENT);
#endif
    } SEAM(2);
    if (IN(3)) { REP(3) { FRESH(); p3_attention(F, rep_ * 2); if (MK_DUP == 3) GRID_BAR(); }
        if (MK_DUP >= 30 && MK_DUP <= 32) { GRID_BAR(); FRESH(); p3_attention(F, 2, 1 << (MK_DUP - 30)); } } SEAM(3);
#if defined(MK_DEBUG)
    if (IN(4)) { FRESH(); dbg_check(F); p4_scan_combine(F); }
    if (IN(5)) { FRESH(); dbg_attn_check(F); }
    if (IN(6)) { FRESH(); dbg_report(F); }
    if (lo >= 4) return;
#endif
    if (IN(4)) { REP(4) { FRESH(); p4_scan_combine(F); if (MK_DUP == 4) GRID_BAR(); } } SEAM(4);
    if (IN(5)) { REP(5) { FRESH(); p5_mlstm_out(F); if (MK_DUP == 5) GRID_BAR(); } } SEAM(5);
    if (IN(6)) REP(6) {
        { pg8::Gemm g{(const bf16*)(F.ws + WS_YA), (const bf16*)(F.ws + WS_WUA), T, 1024, 512}; pg8::StaticOrder S; S.init(T, 1024, F.G, (int)blockIdx.x);
          pg8::EpiGateMul E{(const bf16*)(F.ws + WS_GA), nullptr, (bf16*)(F.ws + WS_T1)};
          pg8::gemm_phase<pg8::EpiGateMul, pg8::StaticOrder, true, true>(F.lds, g, S, E, F.wave); }
        { pg8::Gemm g{(const bf16*)(F.ws + WS_YM), (const bf16*)(F.ws + WS_WUM), T, 1024, 512}; pg8::StaticOrder S; S.init(T, 1024, F.G, (int)blockIdx.x);
          pg8::EpiGateMul E{(const bf16*)(F.ws + WS_GM), (const bf16*)(F.ws + WS_T1), (bf16*)(F.ws + WS_MERGED)};
          pg8::gemm_phase<pg8::EpiGateMul, pg8::StaticOrder, true, true>(F.lds, g, S, E, F.wave); }
    } SEAM(6);
    if (IN(7)) REP(7) {
        pg8::Gemm g{(const bf16*)(F.ws + WS_MERGED), (const bf16*)(F.ws + WS_WOUT), T, 1024, 1024}; pg8::StaticOrder S; S.init(T, 1024, F.G, (int)blockIdx.x);
        pg8::EpiResF32 E{F.in[I_X], F.out};
        pg8::gemm_phase<pg8::EpiResF32, pg8::StaticOrder, true, true>(F.lds, g, S, E, F.wave);
    } SEAM(7);
    if (IN(8)) { for (int rep_ = 0; rep_ < (MK_DUP == 80 ? 2 : 1); ++rep_) { FRESH(); p8_convert(F); if (MK_DUP == 80) GRID_BAR(); }
        for (int rep_ = 0; rep_ < (MK_DUP == 81 ? 2 : 1); ++rep_) { FRESH(); p8_route(F); if (MK_DUP == 81) GRID_BAR(); } } SEAM(8);
    if (IN(9)) { REP(9) { FRESH(); p9_permute(F); if (MK_DUP == 9) GRID_BAR(); } } SEAM(9);
    if (IN(10)) REP(10) {
        const int* BLKE = (const int*)(F.ws + WS_BLKE); const int nblk = BLKE[192];
        pg8::Gemm g{(const bf16*)(F.ws + WS_XS), (const bf16*)(F.ws + WS_WEUP), 40960, 32768, 1024}; pg8::MoeOrder S{BLKE, nblk * 4, F.G, F.vcu};
        pg8::EpiMoeUp E{(bf16*)(F.ws + WS_HID)};
        pg8::gemm_phase<pg8::EpiMoeUp, pg8::MoeOrder, true, true>(F.lds, g, S, E, F.wave);
    } SEAM(10);
    if (IN(11)) REP(11) {
        const int* BLKE = (const int*)(F.ws + WS_BLKE); const int nblk = BLKE[192];
        pg8::Gemm g{(const bf16*)(F.ws + WS_HID), (const bf16*)(F.ws + WS_WEDN), 40960, 32768, 512}; pg8::MoeOrder S{BLKE, nblk * 4, F.G, F.vcu};
        pg8::EpiMoeDown E{(bf16*)(F.ws + WS_YB), (const float*)(F.ws + WS_ROWW)};
        pg8::gemm_phase<pg8::EpiMoeDown, pg8::MoeOrder, true, true>(F.lds, g, S, E, F.wave);
    } SEAM(11);
    if (IN(12)) { FRESH(); p12_combine(F); } SEAM(12);
    if (IN(13)) {
        { pg8::Gemm g{(const bf16*)(F.ws + WS_PB), (const bf16*)(F.ws + WS_WPP), T, 1024, 256}; pg8::StaticOrder S; S.init(T, 1024, F.G, (int)blockIdx.x);
          pg8::EpiPlain E{(bf16*)(F.ws + WS_PJ)};
          pg8::gemm_phase<pg8::EpiPlain, pg8::StaticOrder, true, true>(F.lds, g, S, E, F.wave); }
        { pg8::Gemm g{XN, (const bf16*)(F.ws + WS_WPG), T, 1024, 1024}; pg8::StaticOrder S; S.init(T, 1024, F.G, (int)blockIdx.x);
          pg8::EpiPleGate E{(const bf16*)(F.ws + WS_PJ), F.out};
          pg8::gemm_phase<pg8::EpiPleGate, pg8::StaticOrder, true, true>(F.lds, g, S, E, F.wave); }
    } SEAM(13);
    if (IN(14)) { FRESH(); p14_final(F); }
#if defined(MK_TSA)
    STAMP(14);
    if (blockIdx.x == 0) { const unsigned long long* ts = (const unsigned long long*)(F.ws + 512 * 1024);
        const float da = (float)(ts[MK_TSA + 1] - ts[MK_TSA]) * 0.01f * MK_TSA_SCALE, db = (float)(ts[MK_TSB + 1] - ts[MK_TSB]) * 0.001f;
        __syncthreads(); FRESH();
        if (F.tid == 0) F.out[0] = da;
        for (int i = F.tid; i < 1000; i += NWAVES * 64) F.out[1024 + i] = db; }
#endif
#if defined(MK_DUMP)
    if (lo == MK_DUMP) { FRESH(); dbg_dump_bf16(F, MK_DUMP_OFF, MK_DUMP_LD, MK_DUMP_NC); }
#endif
#undef IN
#undef SEAM
}

extern "C" void kernel_launch(void* const* d_in, const int* in_sizes, int n_in, void* d_out, int out_size, void* d_ws, size_t ws_size, hipStream_t stream) {
    static int grid = 0;
    if (grid == 0) {
        if (n_in != 24 || in_sizes[0] != T * D || out_size != T * D || ws_size < WS_END) { fprintf(stderr, "kernel_launch: shape/workspace mismatch (n_in %d, in0 %d, out %d, ws %zu < %zu)\n", n_in, n_in > 0 ? in_sizes[0] : -1, out_size, ws_size, (size_t)WS_END); grid = -1; return; }
        int dev = 0, cus = 0, per_cu = 0;
        if (hipGetDevice(&dev) != hipSuccess || hipDeviceGetAttribute(&cus, hipDeviceAttributeMultiprocessorCount, dev) != hipSuccess) { grid = -1; return; }
        if (hipFuncSetAttribute((const void*)mk_fwd, hipFuncAttributeMaxDynamicSharedMemorySize, LDS_BYTES) != hipSuccess) { fprintf(stderr, "kernel_launch: hipFuncSetAttribute failed\n"); grid = -1; return; }
        if (hipOccupancyMaxActiveBlocksPerMultiprocessor(&per_cu, (const void*)mk_fwd, NWAVES * 64, LDS_BYTES) != hipSuccess || per_cu < 1) { fprintf(stderr, "kernel_launch: occupancy query says %d blocks per CU\n", per_cu); (void)hipGetLastError(); grid = -1; return; }
        if (cus != 256) { fprintf(stderr, "kernel_launch: built for 256 CUs, device has %d\n", cus); grid = -1; return; }
        grid = cus;
    }
    if (grid < 0) return;
    (void)hipMemsetAsync((char*)d_ws + WS_CTL, 0, CTL_ZERO_BYTES, stream);
    Args a{};
    for (int i = 0; i < 24; ++i) a.in[i] = (const float*)d_in[i];
    a.out = (float*)d_out; a.ws = (unsigned char*)d_ws;
#if MK_PER_PHASE
    for (int ph = 0; ph < NPH; ++ph) { a.ph_lo = ph; a.ph_hi = ph + 1; hipLaunchKernelGGL(mk_fwd, dim3(grid), dim3(NWAVES * 64), LDS_BYTES, stream, a); }
#else
    a.ph_lo = 0; a.ph_hi = NPH; hipLaunchKernelGGL(mk_fwd, dim3(grid), dim3(NWAVES * 64), LDS_BYTES, stream, a);
#endif
}
```
